# Optimizing an MI355X kernel written in HIP

```python
import math
import jax, jax.numpy as jnp
from jax import lax
import numpy as np

D_MODEL = 2048
BATCH = 2
SEQ = 8192
DEPTH = 1

EPS = 1e-6
NEG = -1e30
BLOCK = 128
SWA_HEADS = 16
SWA_KV_HEADS = 4
SWA_HEAD_DIM = 64
SWA_WINDOW = 128
SWA_Q_W = SWA_HEADS * SWA_HEAD_DIM
SWA_KV_W = SWA_KV_HEADS * SWA_HEAD_DIM
MLA_HEADS = 8
MLA_Q_RANK = 512
MLA_KV_RANK = 256
MLA_NOPE_DIM = 128
MLA_ROPE_DIM = 64
MLA_V_DIM = 128
MLA_V_W = MLA_HEADS * MLA_V_DIM
ROPE_THETA = 10000.0
PEER_HEADS = 8
PEER_N_KEYS = 128
PEER_N_EXPERTS = PEER_N_KEYS * PEER_N_KEYS
PEER_QUERY_DIM = 256
PEER_HALF = PEER_QUERY_DIM // 2
PEER_TOPK = 16
PEER_TOKEN_CHUNK = 128
IN_WIDTHS = [SWA_Q_W, SWA_KV_W, SWA_KV_W, MLA_Q_RANK, MLA_KV_RANK, MLA_ROPE_DIM, D_MODEL, D_MODEL]
IN_WIDTH = sum(IN_WIDTHS)
IN_OFFSETS = [int(o) for o in np.cumsum(IN_WIDTHS)[:-1]]

kernel_name = "hybrid_swa_mla_peer_block"


def rms_norm(x, g):
    xf = x.astype(jnp.float32)
    y = xf * lax.rsqrt(jnp.mean(xf * xf, axis=-1, keepdims=True) + EPS)
    return (y * g.astype(jnp.float32)).astype(x.dtype)


def alibi_slopes(n_heads):
    return jnp.asarray([2.0 ** (-8.0 * (h + 1) / n_heads) for h in range(n_heads)], dtype=jnp.float32)


def rope_tables(pos, dim):
    inv = 1.0 / (ROPE_THETA ** (jnp.arange(0, dim, 2, dtype=jnp.float32) / dim))
    ang = pos.astype(jnp.float32)[..., None] * inv
    return jnp.cos(ang), jnp.sin(ang)


def apply_rope(t, cos, sin):
    tf = t.astype(jnp.float32)
    t1, t2 = jnp.split(tf, 2, axis=-1)
    out = jnp.concatenate([t1 * cos - t2 * sin, t1 * sin + t2 * cos], axis=-1)
    return out.astype(t.dtype)


def with_prev_block(t):
    prev = jnp.concatenate([jnp.zeros_like(t[:, :1]), t[:, :-1]], axis=1)
    return jnp.concatenate([prev, t], axis=2)


def swa_attention(q, k, v, pos, sinks):
    B, S = q.shape[:2]
    nb = S // BLOCK
    G = SWA_HEADS // SWA_KV_HEADS
    qb = q.reshape(B, nb, BLOCK, SWA_KV_HEADS, G, SWA_HEAD_DIM)
    kk = with_prev_block(k.reshape(B, nb, BLOCK, SWA_KV_HEADS, SWA_HEAD_DIM))
    vv = with_prev_block(v.reshape(B, nb, BLOCK, SWA_KV_HEADS, SWA_HEAD_DIM))
    pq = pos.astype(jnp.float32).reshape(B, nb, BLOCK)
    pk = with_prev_block(pq)
    logits = jnp.einsum('bnqhgd,bnkhd->bnhgqk', qb, kk).astype(jnp.float32) * (SWA_HEAD_DIM ** -0.5)
    dist = jnp.abs(pq[:, :, :, None] - pk[:, :, None, :])
    slopes = alibi_slopes(SWA_HEADS).reshape(SWA_KV_HEADS, G, 1, 1)
    logits = logits - slopes * dist[:, :, None, None]
    qi = jnp.arange(BLOCK)[:, None]
    kj = jnp.arange(2 * BLOCK)[None, :]
    rel = BLOCK + qi - kj
    band = (rel >= 0) & (rel < SWA_WINDOW)
    valid_prev = (jnp.arange(nb)[:, None, None] > 0) | (kj >= BLOCK)[None]
    mask = band[None] & valid_prev
    logits = jnp.where(mask[None, :, None, None], logits, NEG)
    sink = sinks.astype(jnp.float32).reshape(1, 1, SWA_KV_HEADS, G, 1, 1)
    m = jnp.maximum(jnp.max(logits, axis=-1, keepdims=True), sink)
    p = jnp.exp(logits - m)
    probs = (p / (jnp.sum(p, axis=-1, keepdims=True) + jnp.exp(sink - m))).astype(v.dtype)
    out = jnp.einsum('bnhgqk,bnkhd->bnqhgd', probs, vv)
    return out.reshape(B, S, SWA_Q_W)


def mla_attention(c_q, c_kv, k_rope_raw, pos, g_cq, w_uq, g_ckv, w_ukv):
    B, S = c_q.shape[:2]
    nb = S // BLOCK
    q = (rms_norm(c_q, g_cq) @ w_uq).reshape(B, S, MLA_HEADS, MLA_NOPE_DIM + MLA_ROPE_DIM)
    q_nope, q_rope = q[..., :MLA_NOPE_DIM], q[..., MLA_NOPE_DIM:]
    kv = (rms_norm(c_kv, g_ckv) @ w_ukv).reshape(B, S, MLA_HEADS, MLA_NOPE_DIM + MLA_V_DIM)
    k_nope, v = kv[..., :MLA_NOPE_DIM], kv[..., MLA_NOPE_DIM:]
    cos, sin = rope_tables(pos, MLA_ROPE_DIM)
    q_rope = apply_rope(q_rope, cos[:, :, None], sin[:, :, None])
    k_rope = apply_rope(k_rope_raw, cos, sin)
    scale = (MLA_NOPE_DIM + MLA_ROPE_DIM) ** -0.5
    qn_b = q_nope.reshape(B, nb, BLOCK, MLA_HEADS, MLA_NOPE_DIM).swapaxes(0, 1)
    qr_b = q_rope.reshape(B, nb, BLOCK, MLA_HEADS, MLA_ROPE_DIM).swapaxes(0, 1)
    key_idx = jnp.arange(S)

    def one_block(args):
        qn, qr, i = args
        s = (jnp.einsum('bqhd,bkhd->bhqk', qn, k_nope)
             + jnp.einsum('bqhr,bkr->bhqk', qr, k_rope)).astype(jnp.float32) * scale
        q_idx = i * BLOCK + jnp.arange(BLOCK)
        s = jnp.where(key_idx[None, :] <= q_idx[:, None], s, NEG)
        p = jax.nn.softmax(s, axis=-1).astype(v.dtype)
        return jnp.einsum('bhqk,bkhd->bqhd', p, v)

    out = lax.map(one_block, (qn_b, qr_b, jnp.arange(nb)))
    return out.swapaxes(0, 1).reshape(B, S, MLA_V_W)


def peer_ffn(h, w_q, keys, u, v):
    B, S, D = h.shape
    q = (h @ w_q).reshape(B, S, PEER_HEADS, 2, PEER_HALF)
    s = jnp.einsum('bshpd,hpnd->bshpn', q, keys).astype(jnp.float32)
    top_s, top_i = lax.top_k(s, PEER_TOPK)
    cand_s = (top_s[..., 0, :, None] + top_s[..., 1, None, :]).reshape(B, S, PEER_HEADS, PEER_TOPK * PEER_TOPK)
    cand_i = (top_i[..., 0, :, None] * PEER_N_KEYS + top_i[..., 1, None, :]).reshape(B, S, PEER_HEADS, PEER_TOPK * PEER_TOPK)
    best_s, best_pos = lax.top_k(cand_s, PEER_TOPK)
    expert = jnp.take_along_axis(cand_i, best_pos, axis=-1)
    gate = jax.nn.softmax(best_s, axis=-1)
    T = B * S
    HK = PEER_HEADS * PEER_TOPK
    nc = T // PEER_TOKEN_CHUNK
    xt = h.reshape(nc, PEER_TOKEN_CHUNK, D)
    it = expert.reshape(nc, PEER_TOKEN_CHUNK, HK)
    gt = gate.reshape(nc, PEER_TOKEN_CHUNK, HK)

    def one_chunk(args):
        xc, ic, gc = args
        a = jnp.einsum('cd,ced->ce', xc, u[ic])
        w = (jax.nn.gelu(a.astype(jnp.float32), approximate=False) * gc).astype(xc.dtype)
        return jnp.einsum('ce,ced->cd', w, v[ic])

    out = lax.map(one_chunk, (xt, it, gt))
    return out.reshape(B, S, D)


def setup_inputs(seed: int = 0) -> dict:
    key = jax.random.key(seed)
    ks = jax.random.split(key, 20)
    f32 = jnp.float32

    def nrm(k, shape, scale):
        return jax.random.normal(k, shape, f32) * scale

    def gain(k, shape):
        return 1.0 + 0.02 * jax.random.normal(k, shape, f32)

    x = jax.random.normal(ks[0], (BATCH, SEQ, D_MODEL), f32)
    offset = jax.random.randint(ks[1], (BATCH, 1), 0, 1024, dtype=jnp.int32)
    positions = (offset + jnp.arange(SEQ, dtype=jnp.int32)[None, :]).astype(jnp.int32)
    return {
        "x": x,
        "positions": positions,
        "g_mix": gain(ks[2], (DEPTH, D_MODEL)),
        "w_in": nrm(ks[3], (DEPTH, D_MODEL, IN_WIDTH), D_MODEL ** -0.5),
        "sinks": nrm(ks[4], (DEPTH, SWA_HEADS), 0.5),
        "g_cq": gain(ks[5], (DEPTH, MLA_Q_RANK)),
        "w_uq": nrm(ks[6], (DEPTH, MLA_Q_RANK, MLA_HEADS * (MLA_NOPE_DIM + MLA_ROPE_DIM)), MLA_Q_RANK ** -0.5),
        "g_ckv": gain(ks[7], (DEPTH, MLA_KV_RANK)),
        "w_ukv": nrm(ks[8], (DEPTH, MLA_KV_RANK, MLA_HEADS * (MLA_NOPE_DIM + MLA_V_DIM)), MLA_KV_RANK ** -0.5),
        "w_a_proj": nrm(ks[9], (DEPTH, SWA_Q_W, D_MODEL), SWA_Q_W ** -0.5),
        "w_b_proj": nrm(ks[10], (DEPTH, MLA_V_W, D_MODEL), MLA_V_W ** -0.5),
        "w_o": nrm(ks[11], (DEPTH, D_MODEL, D_MODEL), D_MODEL ** -0.5),
        "g_ffn": gain(ks[12], (DEPTH, D_MODEL)),
        "w_peer_q": nrm(ks[13], (DEPTH, D_MODEL, PEER_HEADS * PEER_QUERY_DIM), D_MODEL ** -0.5),
        "peer_keys": nrm(ks[14], (DEPTH, PEER_HEADS, 2, PEER_N_KEYS, PEER_HALF), PEER_HALF ** -0.5),
        "peer_u": nrm(ks[15], (DEPTH, PEER_N_EXPERTS, D_MODEL), D_MODEL ** -0.5),
        "peer_v": nrm(ks[16], (DEPTH, PEER_N_EXPERTS, D_MODEL), (PEER_HEADS * PEER_TOPK) ** -0.5),
        "g_final": gain(ks[17], (D_MODEL,)),
    }


def reference(x, positions, g_mix, w_in, sinks, g_cq, w_uq, g_ckv, w_ukv, w_a_proj, w_b_proj, w_o,
              g_ffn, w_peer_q, peer_keys, peer_u, peer_v, g_final):
    for l in range(DEPTH):
        h = rms_norm(x, g_mix[l])
        z = h @ w_in[l]
        q_a, k_a, v_a, c_q, c_kv, k_r, gate_a, gate_b = jnp.split(z, IN_OFFSETS, axis=-1)
        y_a = swa_attention(q_a, k_a, v_a, positions, sinks[l]) @ w_a_proj[l]
        y_b = mla_attention(c_q, c_kv, k_r, positions, g_cq[l], w_uq[l], g_ckv[l], w_ukv[l]) @ w_b_proj[l]
        mixed = jax.nn.sigmoid(gate_a) * y_a + jax.nn.sigmoid(gate_b) * y_b
        x = x + mixed @ w_o[l]
        x = x + peer_ffn(rms_norm(x, g_ffn[l]), w_peer_q[l], peer_keys[l], peer_u[l], peer_v[l])
    return rms_norm(x, g_final)
```

```cpp
#include <hip/hip_runtime.h>
#include <hip/hip_bf16.h>
#include <hip/hip_cooperative_groups.h>
#include <cstdio>
#include <cstdint>
#include <cmath>
namespace cg = cooperative_groups;

constexpr int BATCH = 2, SEQ = 8192, DM = 2048, T = BATCH * SEQ;
constexpr int NWAVES = 8, NTHREADS = 512;
constexpr int IN_W = 6464, IN_WP = 6656, IN_WB = 2560, IN_WG = 4096;
constexpr float H8_SCALE = 16.f, WG8_SCALE = 2048.f;
constexpr float EPS = 1e-6f;

typedef unsigned short bf16_t;
typedef short bf16x8 __attribute__((ext_vector_type(8)));
typedef float f32x4 __attribute__((ext_vector_type(4)));
typedef float f32x16 __attribute__((ext_vector_type(16)));
typedef unsigned u32x4 __attribute__((ext_vector_type(4)));
typedef unsigned u32x2 __attribute__((ext_vector_type(2)));
typedef short s16x4 __attribute__((ext_vector_type(4)));
#define LAS __attribute__((address_space(3)))

typedef float f32x2_t __attribute__((ext_vector_type(2))); typedef __bf16 bf16x2v_t __attribute__((ext_vector_type(2)));
__device__ __forceinline__ unsigned cvt_pk_bf16(float lo, float hi) { f32x2_t v = {lo, hi}; bf16x2v_t b = __builtin_convertvector(v, bf16x2v_t); return __builtin_bit_cast(unsigned, b); }
__device__ __forceinline__ float bf_lo(unsigned w) { return __uint_as_float(w << 16); }
__device__ __forceinline__ float bf_hi(unsigned w) { return __uint_as_float(w & 0xffff0000u); }
__device__ __forceinline__ u32x4 pack8u(f32x4 a, f32x4 b) { u32x4 w = {cvt_pk_bf16(a[0], a[1]), cvt_pk_bf16(a[2], a[3]), cvt_pk_bf16(b[0], b[1]), cvt_pk_bf16(b[2], b[3])}; return w; }
__device__ __forceinline__ bf16x8 pack8(f32x4 a, f32x4 b) { u32x4 w = pack8u(a, b); return __builtin_bit_cast(bf16x8, w); }
__device__ __forceinline__ int opaque_tid() { int t = threadIdx.x; asm volatile("" : "+v"(t)); return t; }
__device__ __forceinline__ const char* uni_ptr(const void* p) {
    const unsigned long long v = (unsigned long long)p; const unsigned lo = __builtin_amdgcn_readfirstlane((unsigned)v), hi = __builtin_amdgcn_readfirstlane((unsigned)(v >> 32));
    return (const char*)(((unsigned long long)hi << 32) | lo);
}
__device__ __forceinline__ unsigned pack_i8x4(f32x4 y) {
    const int a = (int)rintf(y[0]), b = (int)rintf(y[1]), c = (int)rintf(y[2]), d = (int)rintf(y[3]);
    return (unsigned)(a & 0xff) | ((unsigned)(b & 0xff) << 8) | ((unsigned)(c & 0xff) << 16) | ((unsigned)d << 24);
}
__device__ __forceinline__ float wave_sum(float v) {
#pragma unroll
    for (int o = 1; o < 64; o <<= 1) v += __shfl_xor(v, o);
    return v;
}

constexpr size_t MiB = 1u << 20;
constexpr size_t WS_COS = 1 * MiB, WS_SIN = 3 * MiB, WS_SSQ = 5 * MiB, WS_KR = 6 * MiB;
constexpr size_t WS_WIN = 8 * MiB, WS_WUQ = 34 * MiB, WS_WUKV = 36 * MiB, WS_WA = 37 * MiB, WS_WB = 41 * MiB, WS_WO = 45 * MiB, WS_WPK = 53 * MiB;
constexpr size_t WS_CTL = 0, CTL_ZERO_BYTES = 16384;
constexpr size_t WS_PU = 61 * MiB, WS_PV = 93 * MiB, WS_SCU = 125 * MiB, WS_SCV = 125 * MiB + 65536;
constexpr size_t WS_H = 189 * MiB;
constexpr size_t WS_QA = 253 * MiB, WS_KA = 285 * MiB, WS_VA = 293 * MiB, WS_CQ = 301 * MiB, WS_CKV = 317 * MiB;
constexpr size_t WS_RI = 461 * MiB, WS_RG = 469 * MiB;
constexpr size_t WS_XQ = 8 * MiB, WS_SX = 125 * MiB + 131072;
constexpr size_t WS_H8 = 325 * MiB, WS_WG8 = 357 * MiB;
constexpr size_t WS_Y = 253 * MiB;
constexpr size_t WS_QN = 325 * MiB, WS_QR = 357 * MiB, WS_KN = 373 * MiB, WS_V = 405 * MiB;
constexpr size_t WS_AA = 437 * MiB, WS_AB = 469 * MiB, WS_END = 501 * MiB;
constexpr size_t WS_MX = 325 * MiB;
constexpr size_t WS_SC = 325 * MiB;
constexpr size_t WS_AP = 325 * MiB, WS_CF = 453 * MiB, WS_SSQ2 = 5 * MiB;


#define XB_TMO      128
#define XB_XCNT(j)  (256  + 64 * (j))
#define XB_XSUB(j)  (1280 + 64 * (j))
#define XB_XGEN(j)  (2304 + 64 * (j))
#define XB_TOP      3328
#define XB_TOPGEN   3392
#define XCD_BAR_WORDS 3456
#define XB_SPIN_CAP (1u << 22)
__device__ __forceinline__ unsigned xb_ld(unsigned* p)              { return __hip_atomic_load(p, __ATOMIC_RELAXED, __HIP_MEMORY_SCOPE_AGENT); }
__device__ __forceinline__ unsigned xb_add(unsigned* p, unsigned v) { return __hip_atomic_fetch_add(p, v, __ATOMIC_RELAXED, __HIP_MEMORY_SCOPE_AGENT); }
__device__ __forceinline__ unsigned xb_xcc_id() { return (unsigned)__builtin_amdgcn_s_getreg((3 << 11) | 20) & 0xFu; }
#define XB_SPIN(cond, bar) do { unsigned _sp = 0; while (cond) { __builtin_amdgcn_s_sleep(1); \
    if ((++_sp & 255u) == 0u) { if (xb_ld(&(bar)[XB_TMO])) break; if (_sp > XB_SPIN_CAP) { atomicAdd(&(bar)[XB_TMO], 1u); break; } } } } while (0)
struct XcdBarrier { unsigned* bar; unsigned x; volatile LAS unsigned* st; };
__device__ __forceinline__ XcdBarrier xcd_barrier_post(unsigned* bar, volatile LAS unsigned* st) {
    XcdBarrier b; b.bar = bar; b.x = xb_xcc_id(); b.st = st;
    if (threadIdx.x == 0) st[2] = xb_add(&bar[XB_XCNT(b.x)], 1u);
    return b;
}
__device__ __forceinline__ void xcd_barrier_complete(unsigned* bar, unsigned x, unsigned& nloc, unsigned& nx, unsigned& xi) {
    const unsigned G = gridDim.x * gridDim.y * gridDim.z;
    unsigned sum, cnt, mine, below, sp = 0u;
    for (;;) {
        sum = 0u; cnt = 0u; mine = 0u; below = 0u;
#pragma unroll
        for (unsigned j = 0; j < 16; ++j) { const unsigned c = xb_ld(&bar[XB_XCNT(j)]); sum += c; cnt += (c > 0u) ? 1u : 0u; mine = (j == x) ? c : mine; below += (c > 0u && j < x) ? 1u : 0u; }
        if (sum == G) break;
        __builtin_amdgcn_s_sleep(1);
        if ((++sp & 255u) == 0u) { if (xb_ld(&bar[XB_TMO])) break; if (sp > XB_SPIN_CAP) { atomicAdd(&bar[XB_TMO], 1u); break; } }
    }
    nloc = mine > 0u ? mine : 1u; nx = cnt > 0u ? cnt : 1u; xi = below;
}
__device__ __forceinline__ void xcd_barrier(const XcdBarrier& b) {
    asm volatile("s_waitcnt vmcnt(0)" ::: "memory");
    __syncthreads();
    if (threadIdx.x == 0) {
        unsigned* bar = b.bar;
        __builtin_amdgcn_s_waitcnt(0);
        unsigned nloc = b.st[0], nx = b.st[1];
        if (nloc == 0u) { unsigned xi = 0u; xcd_barrier_complete(bar, b.x, nloc, nx, xi); b.st[0] = nloc; b.st[1] = nx; b.st[3] = xi; }
        const unsigned old = xb_add(&bar[XB_XSUB(b.x)], 1u);
        const unsigned gen = old / nloc;
        if (old + 1u == (gen + 1u) * nloc) {
            __builtin_amdgcn_fence(__ATOMIC_RELEASE, "agent");
            asm volatile("s_waitcnt vmcnt(0)" ::: "memory");
            const unsigned og = xb_add(&bar[XB_TOP], 1u);
            const unsigned tg = og / nx;
            if (og + 1u == (tg + 1u) * nx) xb_add(&bar[XB_TOPGEN], 1u);
            else XB_SPIN(xb_ld(&bar[XB_TOPGEN]) == tg, bar);
            __builtin_amdgcn_fence(__ATOMIC_ACQUIRE, "agent");
            xb_add(&bar[XB_XGEN(b.x)], 1u);
            asm volatile("s_waitcnt vmcnt(0)" ::: "memory");
        } else {
            XB_SPIN(xb_ld(&bar[XB_XGEN(b.x)]) == gen, bar);
            __builtin_amdgcn_fence(__ATOMIC_ACQUIRE, "agent");
            asm volatile("s_waitcnt vmcnt(0)" ::: "memory");
        }
    }
    __syncthreads();
}

namespace pg8 {
#define PG8_LAS __attribute__((address_space(3)))
constexpr int BM = 256, BK = 64, HALF = 128, HTB = HALF * BK * 2, STAGE_BYTES = 8 * HTB, NXCD = 8, WGM = 8;
__host__ __device__ __forceinline__ int lds_byte(int r, int c) { const int st = (r >> 4) * 2 + (c >> 5), rr = r & 15, cc = c & 31, ob = rr * 64 + cc * 2; return st * 1024 + (ob ^ (((ob >> 9) & 1) << 5)); }
__host__ __device__ __forceinline__ void stage_rc(int b, int& R, int& C) { const int st = b / 1024, sb = b % 1024, swz = sb ^ (((sb >> 9) & 1) << 5); R = (st >> 1) * 16 + swz / 64; C = (st & 1) * 32 + (swz % 64) / 2; }
__host__ __device__ __forceinline__ int perm32(int rho) { const int n = rho >> 4, i = rho & 15; return 8 * (i >> 2) + 4 * n + (i & 3); }
struct Unit { int pm, pn, seg; };
struct Gemm { const bf16_t* A; const bf16_t* Bt; int M, N, K; const bf16_t* A2; const bf16_t* Bt2; };
struct StaticOrder {
    int nM, nN, nwg, G, c;
    __host__ __device__ void init(int M, int N, int G_, int c_) { nM = M / BM; nN = N / BM; nwg = nM * nN; G = G_; c = c_; }
    __host__ __device__ bool next(int i, Unit& u) const {
        const long L = (long)i * G + c; if (L >= nwg) return false;
        int wgid = (int)L; { const int q = nwg / NXCD, r = nwg % NXCD, xcd = wgid % NXCD, off = wgid / NXCD; wgid = (xcd < r ? xcd * (q + 1) : r * (q + 1) + (xcd - r) * q) + off; }
        const int nig = WGM * nN, gid = wgid / nig, fm = gid * WGM, gsz = (nM - fm) < WGM ? (nM - fm) : WGM;
        u.pm = fm + ((wgid % nig) % gsz); u.pn = (wgid % nig) / gsz; u.seg = 0; return true;
    }
    __device__ __forceinline__ void a_ready(const Unit&) const {}
    __device__ __forceinline__ void done(const Unit&) const {}
};
struct GateOrder {
    StaticOrder base; int c, G;
    __host__ __device__ void init(int M, int N, int G_, int c_) { base.init(M, N, G_, 0); c = c_; G = G_; }
    __host__ __device__ bool next(int i, Unit& u) const {
        const int h = G / 2; int L;
        if (G != 256 || base.nwg != 1024) { L = i * G + c; }
        else if (c < h) { if (i >= 3) return false; L = c + h * i; }
        else { if (i >= 5) return false; L = 3 * h + (c - h) + h * i; }
        if (L >= base.nwg) return false;
        StaticOrder b2 = base; b2.G = 1; b2.c = L; return b2.next(0, u);
    }
    __device__ __forceinline__ void a_ready(const Unit&) const {}
    __device__ __forceinline__ void done(const Unit&) const {}
};
struct TwoSegOrder {
    StaticOrder base;
    __host__ __device__ void init(int M, int N, int G_, int c_) { base.init(M, N, G_, c_); }
    __host__ __device__ bool next(int i, Unit& u) const { if (!base.next(i >> 1, u)) return false; u.seg = i & 1; return true; }
    __device__ __forceinline__ void a_ready(const Unit&) const {}
    __device__ __forceinline__ void done(const Unit&) const {}
};

typedef int i32x8 __attribute__((ext_vector_type(8)));
typedef unsigned u32x8 __attribute__((ext_vector_type(8)));
template <class Epi, class Sched, bool ALIGN_EPI = false, bool SP2 = false, bool F8 = false>
__device__ __forceinline__ void gemm_phase(PG8_LAS unsigned char* lds, const Gemm g, const Sched& S, const Epi& E) {
    const int tid = opaque_tid(), wid = __builtin_amdgcn_readfirstlane(tid >> 6), lane = tid & 63, wr = wid >> 2, wc = wid & 3, fr = lane & 15, fq = lane >> 4;
    const int K = g.K, nt = K / BK;
    unsigned voffA[2], voffB[2];
#pragma unroll
    for (int i = 0; i < 2; ++i) { int R, C; stage_rc(tid * 16 + i * 8192, R, C); const int Rb = Epi::PERM ? ((R & ~31) + perm32(R & 31)) : R;
        voffA[i] = (unsigned)(R * K + C) * 2u; voffB[i] = (unsigned)(Rb * K + C) * 2u; }
    const size_t kstep = (size_t)(BK * 2);
    const size_t hstep = (size_t)HALF * K * 2;
    const size_t tstep = 2 * hstep;
    const unsigned ldsw = (unsigned)wid * 1024u;
    const int aoff = lds_byte(wr * 64 + fr, fq * 8), boff = lds_byte(wc * 32 + fr, fq * 8);
#define PG8_SA(b, h) (((b) * 2 + (h)) * HTB)
#define PG8_SB(b, h) ((4 + (b) * 2 + (h)) * HTB)
#define PG8_STAGE(bufoff, gbase, voff) do { _Pragma("unroll") for (int _i = 0; _i < 2; ++_i) \
        __builtin_amdgcn_global_load_lds((const unsigned*)((const char*)(gbase) + (voff)[_i]), (PG8_LAS unsigned*)(lds + (bufoff) + ldsw + _i * 8192), 16, 0, 0); } while (0)
#define PG8_CAT(x0, x1) __builtin_shufflevector((x0), (x1), 0, 1, 2, 3, 4, 5, 6, 7)
#define PG8_LO(x) __builtin_bit_cast(bf16x8, __builtin_shufflevector((x), (x), 0, 1, 2, 3))
#define PG8_HI(x) __builtin_bit_cast(bf16x8, __builtin_shufflevector((x), (x), 4, 5, 6, 7))
#define PG8_LDA(dst, b, h) do { _Pragma("unroll") for (int m = 0; m < 4; ++m) dst[m] = PG8_CAT(*(const PG8_LAS u32x4*)(lds + PG8_SA(b, h) + aoff + m * 2048), *(const PG8_LAS u32x4*)(lds + PG8_SA(b, h) + aoff + m * 2048 + 1024)); } while (0)
#define PG8_LDB(dst, b, h) do { _Pragma("unroll") for (int n = 0; n < 2; ++n) dst[n] = PG8_CAT(*(const PG8_LAS u32x4*)(lds + PG8_SB(b, h) + boff + n * 2048), *(const PG8_LAS u32x4*)(lds + PG8_SB(b, h) + boff + n * 2048 + 1024)); } while (0)
#define PG8_MMA(ai, bj, At, Bt) do { __builtin_amdgcn_s_setprio(1); _Pragma("unroll") for (int m = 0; m < 4; ++m) _Pragma("unroll") for (int n = 0; n < 2; ++n) { \
        if constexpr (F8) { asm volatile("v_mfma_scale_f32_16x16x128_f8f6f4 %0, %1, %2, %0, %3, %3 op_sel_hi:[0,0,0]" : "+v"(acc[ai][bj][m][n]) : "v"(Bt[n]), "v"(At[m]), "v"(mxscale)); }     \
        else { acc[ai][bj][m][n] = __builtin_amdgcn_mfma_f32_16x16x32_bf16(PG8_LO(Bt[n]), PG8_LO(At[m]), acc[ai][bj][m][n], 0, 0, 0); \
               acc[ai][bj][m][n] = __builtin_amdgcn_mfma_f32_16x16x32_bf16(PG8_HI(Bt[n]), PG8_HI(At[m]), acc[ai][bj][m][n], 0, 0, 0); } } \
        __builtin_amdgcn_s_setprio(0); } while (0)
#define PG8_WAIT_V(n) asm volatile("s_waitcnt vmcnt(" #n ")" ::: "memory")
#define PG8_WAIT_L(n) asm volatile("s_waitcnt lgkmcnt(" #n ")" ::: "memory")
#define PG8_BAR __builtin_amdgcn_s_barrier()
#define PG8_SCHED __builtin_amdgcn_sched_barrier(0)
    Unit cur, nxt; int ui = 0;
    if (!S.next(0, cur)) return;
    f32x4 acc[2][2][4][2];
#pragma unroll
    for (int a = 0; a < 2; ++a)
#pragma unroll
        for (int b = 0; b < 2; ++b)
#pragma unroll
            for (int m = 0; m < 4; ++m)
#pragma unroll
                for (int n = 0; n < 2; ++n) acc[a][b][m][n] = (f32x4){0.f, 0.f, 0.f, 0.f};
    const unsigned mxscale = 0x7f7f7f7fu;
    u32x8 At[4], B0[2], B1[2];
    const char* cA = (const char*)(cur.seg ? g.A2 : g.A) + (size_t)cur.pm * tstep; const char* cB = (const char*)(cur.seg ? g.Bt2 : g.Bt) + (size_t)cur.pn * tstep;
    S.a_ready(cur);
    if constexpr (SP2) {
        PG8_STAGE(PG8_SB(0, 0), cB, voffB); PG8_STAGE(PG8_SB(0, 1), cB + hstep, voffB); PG8_STAGE(PG8_SA(0, 0), cA, voffA); PG8_STAGE(PG8_SA(0, 1), cA + hstep, voffA);
        if (wr == 1) PG8_BAR;
        PG8_WAIT_V(2); PG8_BAR;
        PG8_STAGE(PG8_SB(1, 0), cB + kstep, voffB); PG8_STAGE(PG8_SA(1, 0), cA + kstep, voffA); PG8_STAGE(PG8_SB(1, 1), cB + hstep + kstep, voffB);
        PG8_WAIT_V(6); PG8_BAR;
    } else {
        PG8_STAGE(PG8_SB(0, 0), cB, voffB); PG8_STAGE(PG8_SA(0, 0), cA, voffA); PG8_STAGE(PG8_SB(0, 1), cB + hstep, voffB); PG8_STAGE(PG8_SA(0, 1), cA + hstep, voffA);
        if (wr == 1) PG8_BAR;
        PG8_WAIT_V(4); PG8_BAR;
        PG8_STAGE(PG8_SB(1, 0), cB + kstep, voffB); PG8_STAGE(PG8_SA(1, 0), cA + kstep, voffA); PG8_STAGE(PG8_SB(1, 1), cB + hstep + kstep, voffB);
        PG8_WAIT_V(6); PG8_BAR;
    }
    for (;;) {
        const bool has_next = S.next(ui + 1, nxt);
        const char* nA = has_next ? (const char*)(nxt.seg ? g.A2 : g.A) + (size_t)nxt.pm * tstep : cA; const char* nB = has_next ? (const char*)(nxt.seg ? g.Bt2 : g.Bt) + (size_t)nxt.pn * tstep : cB;
        for (int t = 0; t < nt; t += 2) {
            const bool last = (t == nt - 2);
            const char* a1 = cA + (size_t)(t + 1) * kstep;
            const char* a2 = last ? nA : cA + (size_t)(t + 2) * kstep; const char* b2 = last ? nB : cB + (size_t)(t + 2) * kstep;
            const char* a3 = a2 + kstep; const char* b3 = b2 + kstep;
            if (last && has_next) S.a_ready(nxt);
            if constexpr (SP2) {
            PG8_LDB(B0, 0, 0); PG8_LDB(B1, 0, 1); PG8_SCHED; PG8_LDA(At, 0, 0); PG8_STAGE(PG8_SA(1, 1), a1 + hstep, voffA);
            PG8_WAIT_V(8); PG8_WAIT_L(0); PG8_BAR; PG8_MMA(0, 0, At, B0); PG8_MMA(0, 1, At, B1); PG8_BAR; PG8_SCHED;
            PG8_LDA(At, 0, 1); PG8_STAGE(PG8_SB(0, 0), b2, voffB); PG8_STAGE(PG8_SB(0, 1), b2 + hstep, voffB); PG8_STAGE(PG8_SA(0, 0), a2, voffA);
            PG8_WAIT_V(8); PG8_WAIT_L(0); PG8_BAR; PG8_MMA(1, 0, At, B0); PG8_MMA(1, 1, At, B1); PG8_BAR; PG8_SCHED;
            PG8_LDB(B0, 1, 0); PG8_LDB(B1, 1, 1); PG8_SCHED; PG8_LDA(At, 1, 0); PG8_STAGE(PG8_SA(0, 1), a2 + hstep, voffA);
            PG8_WAIT_V(8); PG8_WAIT_L(0); PG8_BAR; PG8_MMA(0, 0, At, B0); PG8_MMA(0, 1, At, B1); PG8_BAR; PG8_SCHED;
            PG8_LDA(At, 1, 1); PG8_STAGE(PG8_SB(1, 0), b3, voffB); PG8_STAGE(PG8_SB(1, 1), b3 + hstep, voffB); PG8_STAGE(PG8_SA(1, 0), a3, voffA);
            PG8_WAIT_V(8); PG8_WAIT_L(0); PG8_BAR; PG8_MMA(1, 0, At, B0); PG8_MMA(1, 1, At, B1); PG8_BAR; PG8_SCHED;
            } else {
            PG8_LDB(B0, 0, 0); PG8_SCHED; PG8_LDA(At, 0, 0); PG8_STAGE(PG8_SA(1, 1), a1 + hstep, voffA);
            PG8_WAIT_L(8); PG8_BAR; PG8_WAIT_L(0); PG8_MMA(0, 0, At, B0); PG8_BAR; PG8_SCHED;
            PG8_LDB(B1, 0, 1); PG8_STAGE(PG8_SB(0, 0), b2, voffB);
            PG8_BAR; PG8_WAIT_L(0); PG8_MMA(0, 1, At, B1); PG8_BAR;
            PG8_LDA(At, 0, 1); PG8_STAGE(PG8_SA(0, 0), a2, voffA);
            PG8_BAR; PG8_WAIT_L(0); PG8_MMA(1, 0, At, B0); PG8_BAR; PG8_SCHED;
            PG8_STAGE(PG8_SB(0, 1), b2 + hstep, voffB);
            PG8_WAIT_V(6); PG8_BAR; PG8_MMA(1, 1, At, B1); PG8_BAR;
            PG8_LDB(B0, 1, 0); PG8_SCHED; PG8_LDA(At, 1, 0); PG8_STAGE(PG8_SA(0, 1), a2 + hstep, voffA);
            PG8_WAIT_L(8); PG8_BAR; PG8_WAIT_L(0); PG8_MMA(0, 0, At, B0); PG8_BAR; PG8_SCHED;
            PG8_LDB(B1, 1, 1); PG8_STAGE(PG8_SB(1, 0), b3, voffB);
            PG8_BAR; PG8_WAIT_L(0); PG8_MMA(0, 1, At, B1); PG8_BAR;
            PG8_LDA(At, 1, 1); PG8_STAGE(PG8_SA(1, 0), a3, voffA);
            PG8_BAR; PG8_WAIT_L(0); PG8_MMA(1, 0, At, B0); PG8_BAR; PG8_SCHED;
            PG8_STAGE(PG8_SB(1, 1), b3 + hstep, voffB);
            PG8_WAIT_V(6); PG8_BAR; PG8_MMA(1, 1, At, B1); PG8_BAR;
            }
        }
        if constexpr (ALIGN_EPI) { if (wr == 0) PG8_BAR; }
        if constexpr (F8) asm volatile("s_nop 15\n\ts_nop 15" ::: "memory");
        if constexpr (Epi::TWO_SEG) { if (cur.seg == 0) E.mid(acc, cur, wr, wc, fr, fq); else E(acc, cur, wr, wc, fr, fq); } else { E(acc, cur, wr, wc, fr, fq); }
        S.done(cur);
        if (!has_next) break;
        if (!Epi::TWO_SEG || nxt.seg == 0)
#pragma unroll
        for (int a = 0; a < 2; ++a)
#pragma unroll
            for (int b = 0; b < 2; ++b)
#pragma unroll
                for (int m = 0; m < 4; ++m)
#pragma unroll
                    for (int n = 0; n < 2; ++n) acc[a][b][m][n] = (f32x4){0.f, 0.f, 0.f, 0.f};
        cur = nxt; cA = nA; cB = nB; ++ui;
        if constexpr (ALIGN_EPI) { if (wr == 1) PG8_BAR; }
    }
    PG8_WAIT_V(0);
    if constexpr (!ALIGN_EPI) { if (wr == 0) PG8_BAR; }
    PG8_BAR;
#undef PG8_SA
#undef PG8_SB
#undef PG8_STAGE
#undef PG8_LDA
#undef PG8_LDB
#undef PG8_MMA
#undef PG8_CAT
#undef PG8_LO
#undef PG8_HI
#undef PG8_WAIT_V
#undef PG8_WAIT_L
#undef PG8_BAR
#undef PG8_SCHED
}
}

typedef f32x4 Acc[2][2][4][2];
#define EPI_LOOP_AM _Pragma("unroll") for (int ai = 0; ai < 2; ++ai) _Pragma("unroll") for (int m = 0; m < 4; ++m)

struct EpiIn {
    static constexpr bool PERM = true, AFTER_DRAIN = false, TWO_SEG = false;
    bf16_t *QA, *KA, *VA, *CQ, *CKV, *KR, *SA, *SB; float* SSQ; const float *cosT, *sinT;
    __device__ __forceinline__ void operator()(const Acc& acc, const pg8::Unit& u, int, int, int, int) const {
        const int tid_ = opaque_tid(), wid_ = tid_ >> 6, wr = wid_ >> 2, wc = wid_ & 3, fr = tid_ & 15, fq = (tid_ >> 4) & 3;
        const int pn = u.pn, row0 = u.pm * 256 + wr * 64 + fr, cw = wc * 32 + 8 * fq;
        if (pn == 9) {
            if (wc == 0) {
                EPI_LOOP_AM { const int row = row0 + ai * 128 + m * 16;
                    const f32x4 c0 = *(const f32x4*)(cosT + (size_t)row * 32 + 8 * fq), c1 = *(const f32x4*)(cosT + (size_t)row * 32 + 8 * fq + 4);
                    const f32x4 s0 = *(const f32x4*)(sinT + (size_t)row * 32 + 8 * fq), s1 = *(const f32x4*)(sinT + (size_t)row * 32 + 8 * fq + 4);
                    const f32x4 a0 = acc[ai][0][m][0], a1 = acc[ai][0][m][1], b0 = acc[ai][1][m][0], b1 = acc[ai][1][m][1];
                    *(u32x4*)(KR + (size_t)row * 64 + 8 * fq) = pack8u(a0 * c0 - b0 * s0, a1 * c1 - b1 * s1);
                    *(u32x4*)(KR + (size_t)row * 64 + 32 + 8 * fq) = pack8u(a0 * s0 + b0 * c0, a1 * s1 + b1 * c1); }
            }
            return;
        }
        if (pn >= 10) {
            bf16_t* base = pn < 18 ? SA : SB; const int col0 = (pn < 18 ? pn - 10 : pn - 18) * 256 + cw;
            EPI_LOOP_AM { const int row = row0 + ai * 128 + m * 16;
#pragma unroll
                for (int bj = 0; bj < 2; ++bj) { f32x4 v0 = acc[ai][bj][m][0], v1 = acc[ai][bj][m][1];
#pragma unroll
                    for (int e = 0; e < 4; ++e) { v0[e] = 1.f / (1.f + __expf(-v0[e])); v1[e] = 1.f / (1.f + __expf(-v1[e])); }
                    *(u32x4*)(base + (size_t)row * 2048 + col0 + bj * 128) = pack8u(v0, v1); } }
            return;
        }
        bf16_t* base; int ld, col0, slot = -1;
        if (pn < 4) { base = QA; ld = 1024; col0 = pn * 256; }
        else if (pn == 4) { base = KA; ld = 256; col0 = 0; }
        else if (pn == 5) { base = VA; ld = 256; col0 = 0; }
        else if (pn < 8) { base = CQ; ld = 512; col0 = (pn - 6) * 256; slot = (pn - 6) * 4; }
        else { base = CKV; ld = 256; col0 = 0; slot = 8; }
        EPI_LOOP_AM { const int row = row0 + ai * 128 + m * 16; float ss = 0.f;
#pragma unroll
            for (int bj = 0; bj < 2; ++bj) { const f32x4 v0 = acc[ai][bj][m][0], v1 = acc[ai][bj][m][1];
                ss += (v0[0] * v0[0] + v0[1] * v0[1]) + (v0[2] * v0[2] + v0[3] * v0[3]) + (v1[0] * v1[0] + v1[1] * v1[1]) + (v1[2] * v1[2] + v1[3] * v1[3]);
                *(u32x4*)(base + (size_t)row * ld + col0 + bj * 128 + cw) = pack8u(v0, v1); }
            if (slot >= 0) { ss += __shfl_xor(ss, 16); ss += __shfl_xor(ss, 32); if (fq == 0) SSQ[(size_t)row * 12 + slot + wc] = ss; } }
    }
};

struct EpiGate {
    static constexpr bool PERM = true, AFTER_DRAIN = false, TWO_SEG = false;
    bf16_t *SA, *SB;
    __device__ __forceinline__ void operator()(const Acc& acc, const pg8::Unit& u, int, int, int, int) const {
        const int tid_ = opaque_tid(), wid_ = tid_ >> 6, wr = wid_ >> 2, wc = wid_ & 3, fr = tid_ & 15, fq = (tid_ >> 4) & 3;
        const int pn = u.pn, row0 = u.pm * 256 + wr * 64 + fr, cw = wc * 32 + 8 * fq;
        bf16_t* base = pn < 8 ? SA : SB; const int col0 = (pn & 7) * 256 + cw;
        constexpr float ds = -1.f / (H8_SCALE * WG8_SCALE);
        EPI_LOOP_AM { const int row = row0 + ai * 128 + m * 16;
#pragma unroll
            for (int bj = 0; bj < 2; ++bj) { f32x4 v0 = acc[ai][bj][m][0], v1 = acc[ai][bj][m][1];
#pragma unroll
                for (int e = 0; e < 4; ++e) { v0[e] = 1.f / (1.f + __expf(v0[e] * ds)); v1[e] = 1.f / (1.f + __expf(v1[e] * ds)); }
                *(u32x4*)(base + (size_t)row * 2048 + col0 + bj * 128) = pack8u(v0, v1); } }
    }
};
struct EpiQ {
    static constexpr bool PERM = true, AFTER_DRAIN = false, TWO_SEG = false;
    bf16_t *QN, *QR; const float* SSQ; const float *cosT, *sinT;
    __device__ __forceinline__ void operator()(const Acc& acc, const pg8::Unit& u, int, int, int, int) const {
        const int tid_ = opaque_tid(), wid_ = tid_ >> 6, wr = wid_ >> 2, wc = wid_ & 3, fr = tid_ & 15, fq = (tid_ >> 4) & 3;
        const int pn = u.pn, row0 = u.pm * 256 + wr * 64 + fr, cw = wc * 32 + 8 * fq;
        EPI_LOOP_AM { const int row = row0 + ai * 128 + m * 16;
            const f32x4 q0 = *(const f32x4*)(SSQ + (size_t)row * 12), q1 = *(const f32x4*)(SSQ + (size_t)row * 12 + 4);
            const float rstd = rsqrtf(((q0[0] + q0[1]) + (q0[2] + q0[3]) + (q1[0] + q1[1]) + (q1[2] + q1[3])) * (1.f / 512.f) + EPS);
            if (pn < 4) {
#pragma unroll
                for (int bj = 0; bj < 2; ++bj) *(u32x4*)(QN + (size_t)row * 1024 + pn * 256 + bj * 128 + cw) = pack8u(acc[ai][bj][m][0] * rstd, acc[ai][bj][m][1] * rstd);
            } else {
                const int head = 4 * (pn - 4) + wc;
                const f32x4 c0 = *(const f32x4*)(cosT + (size_t)row * 32 + 8 * fq), c1 = *(const f32x4*)(cosT + (size_t)row * 32 + 8 * fq + 4);
                const f32x4 s0 = *(const f32x4*)(sinT + (size_t)row * 32 + 8 * fq), s1 = *(const f32x4*)(sinT + (size_t)row * 32 + 8 * fq + 4);
                const f32x4 a0 = acc[ai][0][m][0] * rstd, a1 = acc[ai][0][m][1] * rstd, b0 = acc[ai][1][m][0] * rstd, b1 = acc[ai][1][m][1] * rstd;
                *(u32x4*)(QR + (size_t)row * 512 + head * 64 + 8 * fq) = pack8u(a0 * c0 - b0 * s0, a1 * c1 - b1 * s1);
                *(u32x4*)(QR + (size_t)row * 512 + head * 64 + 32 + 8 * fq) = pack8u(a0 * s0 + b0 * c0, a1 * s1 + b1 * c1);
            } }
    }
};

struct EpiKV {
    static constexpr bool PERM = true, AFTER_DRAIN = false, TWO_SEG = false;
    bf16_t *KN, *V; const float* SSQ;
    __device__ __forceinline__ void operator()(const Acc& acc, const pg8::Unit& u, int, int, int, int) const {
        const int tid_ = opaque_tid(), wid_ = tid_ >> 6, wr = wid_ >> 2, wc = wid_ & 3, fr = tid_ & 15, fq = (tid_ >> 4) & 3;
        const int pn = u.pn, row0 = u.pm * 256 + wr * 64 + fr, cw = wc * 32 + 8 * fq;
        EPI_LOOP_AM { const int row = row0 + ai * 128 + m * 16;
            const f32x4 q0 = *(const f32x4*)(SSQ + (size_t)row * 12 + 8);
            const float rstd = rsqrtf(((q0[0] + q0[1]) + (q0[2] + q0[3])) * (1.f / 256.f) + EPS);
            *(u32x4*)(KN + (size_t)row * 1024 + pn * 128 + cw) = pack8u(acc[ai][0][m][0] * rstd, acc[ai][0][m][1] * rstd);
            *(u32x4*)(V + (size_t)row * 1024 + pn * 128 + cw) = pack8u(acc[ai][1][m][0] * rstd, acc[ai][1][m][1] * rstd); }
    }
};

template <int SECOND> struct EpiMix {
    static constexpr bool PERM = true, AFTER_DRAIN = false, TWO_SEG = false;
    bf16_t* MX; const bf16_t* G;
    __device__ __forceinline__ void operator()(const Acc& acc, const pg8::Unit& u, int, int, int, int) const {
        const int tid_ = opaque_tid(), wid_ = tid_ >> 6, wr = wid_ >> 2, wc = wid_ & 3, fr = tid_ & 15, fq = (tid_ >> 4) & 3;
        const int row0 = u.pm * 256 + wr * 64 + fr, col0 = u.pn * 256 + wc * 32 + 8 * fq;
        EPI_LOOP_AM { const int row = row0 + ai * 128 + m * 16;
#pragma unroll
            for (int bj = 0; bj < 2; ++bj) { const size_t off = (size_t)row * 2048 + col0 + bj * 128;
                const u32x4 gw = *(const u32x4*)(G + off);
                f32x4 v0 = acc[ai][bj][m][0], v1 = acc[ai][bj][m][1];
                v0[0] *= bf_lo(gw[0]); v0[1] *= bf_hi(gw[0]); v0[2] *= bf_lo(gw[1]); v0[3] *= bf_hi(gw[1]);
                v1[0] *= bf_lo(gw[2]); v1[1] *= bf_hi(gw[2]); v1[2] *= bf_lo(gw[3]); v1[3] *= bf_hi(gw[3]);
                if (SECOND) { const u32x4 pw = *(const u32x4*)(MX + off);
                    v0[0] += bf_lo(pw[0]); v0[1] += bf_hi(pw[0]); v0[2] += bf_lo(pw[1]); v0[3] += bf_hi(pw[1]);
                    v1[0] += bf_lo(pw[2]); v1[1] += bf_hi(pw[2]); v1[2] += bf_lo(pw[3]); v1[3] += bf_hi(pw[3]); }
                *(u32x4*)(MX + off) = pack8u(v0, v1); } }
    }
};

struct EpiMix2 {
    static constexpr bool PERM = true, AFTER_DRAIN = false, TWO_SEG = true;
    bf16_t* MX; const bf16_t* GA; const bf16_t* GB;
    __device__ __forceinline__ void mid(Acc& acc, const pg8::Unit& u, int, int, int, int) const {
        const int tid_ = opaque_tid(), wid_ = tid_ >> 6, wr = wid_ >> 2, wc = wid_ & 3, fr = tid_ & 15, fq = (tid_ >> 4) & 3;
        const int row0 = u.pm * 256 + wr * 64 + fr, col0 = u.pn * 256 + wc * 32 + 8 * fq;
        EPI_LOOP_AM { const int row = row0 + ai * 128 + m * 16;
#pragma unroll
            for (int bj = 0; bj < 2; ++bj) { const size_t off = (size_t)row * 2048 + col0 + bj * 128;
                const u32x4 ga = *(const u32x4*)(GA + off), gb = *(const u32x4*)(GB + off);
                f32x4& v0 = acc[ai][bj][m][0]; f32x4& v1 = acc[ai][bj][m][1];
                v0[0] *= bf_lo(ga[0]) / bf_lo(gb[0]); v0[1] *= bf_hi(ga[0]) / bf_hi(gb[0]); v0[2] *= bf_lo(ga[1]) / bf_lo(gb[1]); v0[3] *= bf_hi(ga[1]) / bf_hi(gb[1]);
                v1[0] *= bf_lo(ga[2]) / bf_lo(gb[2]); v1[1] *= bf_hi(ga[2]) / bf_hi(gb[2]); v1[2] *= bf_lo(ga[3]) / bf_lo(gb[3]); v1[3] *= bf_hi(ga[3]) / bf_hi(gb[3]); } }
    }
    __device__ __forceinline__ void operator()(const Acc& acc, const pg8::Unit& u, int, int, int, int) const {
        const int tid_ = opaque_tid(), wid_ = tid_ >> 6, wr = wid_ >> 2, wc = wid_ & 3, fr = tid_ & 15, fq = (tid_ >> 4) & 3;
        const int row0 = u.pm * 256 + wr * 64 + fr, col0 = u.pn * 256 + wc * 32 + 8 * fq;
        EPI_LOOP_AM { const int row = row0 + ai * 128 + m * 16;
#pragma unroll
            for (int bj = 0; bj < 2; ++bj) { const size_t off = (size_t)row * 2048 + col0 + bj * 128;
                const u32x4 gb = *(const u32x4*)(GB + off);
                f32x4 v0 = acc[ai][bj][m][0], v1 = acc[ai][bj][m][1];
                v0[0] *= bf_lo(gb[0]); v0[1] *= bf_hi(gb[0]); v0[2] *= bf_lo(gb[1]); v0[3] *= bf_hi(gb[1]);
                v1[0] *= bf_lo(gb[2]); v1[1] *= bf_hi(gb[2]); v1[2] *= bf_lo(gb[3]); v1[3] *= bf_hi(gb[3]);
                *(u32x4*)(MX + off) = pack8u(v0, v1); } }
    }
};
struct EpiY {
    static constexpr bool PERM = true, AFTER_DRAIN = false, TWO_SEG = false;
    bf16_t* Y;
    __device__ __forceinline__ void operator()(const Acc& acc, const pg8::Unit& u, int, int, int, int) const {
        const int tid_ = opaque_tid(), wid_ = tid_ >> 6, wr = wid_ >> 2, wc = wid_ & 3, fr = tid_ & 15, fq = (tid_ >> 4) & 3;
        const int row0 = u.pm * 256 + wr * 64 + fr, col0 = u.pn * 256 + wc * 32 + 8 * fq;
        EPI_LOOP_AM { const int row = row0 + ai * 128 + m * 16;
#pragma unroll
            for (int bj = 0; bj < 2; ++bj) *(u32x4*)(Y + (size_t)row * 2048 + col0 + bj * 128) = pack8u(acc[ai][bj][m][0], acc[ai][bj][m][1]); }
    }
};
struct EpiRes {
    static constexpr bool PERM = false, AFTER_DRAIN = false, TWO_SEG = false;
    const float* base; float* out;
    __device__ __forceinline__ void operator()(const Acc& acc, const pg8::Unit& u, int, int, int, int) const {
        const int tid_ = opaque_tid(), wid_ = tid_ >> 6, wr = wid_ >> 2, wc = wid_ & 3, fr = tid_ & 15, fq = (tid_ >> 4) & 3;
        const int row0 = u.pm * 256 + wr * 64 + fr, col0 = u.pn * 256 + wc * 32 + 4 * fq;
        EPI_LOOP_AM { const int row = row0 + ai * 128 + m * 16;
#pragma unroll
            for (int bj = 0; bj < 2; ++bj)
#pragma unroll
                for (int n = 0; n < 2; ++n) { const size_t off = (size_t)row * 2048 + col0 + bj * 128 + n * 16;
                    *(f32x4*)(out + off) = *(const f32x4*)(base + off) + acc[ai][bj][m][n]; } }
    }
};
struct EpiF32 {
    static constexpr bool PERM = false, AFTER_DRAIN = false, TWO_SEG = false;
    float* out;
    __device__ __forceinline__ void operator()(const Acc& acc, const pg8::Unit& u, int, int, int, int) const {
        const int tid_ = opaque_tid(), wid_ = tid_ >> 6, wr = wid_ >> 2, wc = wid_ & 3, fr = tid_ & 15, fq = (tid_ >> 4) & 3;
        const int row0 = u.pm * 256 + wr * 64 + fr, col0 = u.pn * 256 + wc * 32 + 4 * fq;
        EPI_LOOP_AM { const int row = row0 + ai * 128 + m * 16;
#pragma unroll
            for (int bj = 0; bj < 2; ++bj)
#pragma unroll
                for (int n = 0; n < 2; ++n) *(f32x4*)(out + (size_t)row * 2048 + col0 + bj * 128 + n * 16) = acc[ai][bj][m][n]; }
    }
};

namespace mla {
constexpr int NW = 8, QBLK = 32, KVBLK = 64, QB = NW * QBLK;
constexpr int SHM_V = KVBLK * 128 * 2, SHM_KN = KVBLK * 128 * 2, SHM_KR = KVBLK * 64 * 2;
constexpr int OFF_V = 0, OFF_KN = 2 * SHM_V, OFF_KR = OFF_KN + 2 * SHM_KN, OFF_WS = OFF_KR + 2 * SHM_KR, OFF_QR = OFF_WS + NW * 64 * 4, LDS_BYTES = OFF_QR + NW * 4096;
constexpr float SCALE = 0.07216878364870322f;
constexpr float THR = 8.f;
constexpr int LQN = 1024, LQR = 512, LKN = 1024, LKR = 64, LV = 1024, LO = 1024;
#define KSWZ(row, colB) ((row) * 256 + ((colB) ^ (((row) & 7) << 4)))
#define KRSWZ(row, colB) ((row) * 128 + ((colB) ^ (((row) & 7) << 4)))
#define SBAR() __builtin_amdgcn_sched_barrier(0)
__device__ __forceinline__ int v_st(int k, int c) { const int kk = (k & ~0xC) | ((k & 4) << 1) | ((k & 8) >> 1); return ((kk >> 3) * 4 + (c >> 5)) * 512 + ((kk & 7) * 32 + (c & 31)) * 2; }
__device__ __forceinline__ int v_rd_base(int lane) { return ((lane & 3) << 3) | (((lane >> 2) & 3) << 6) | (((lane >> 4) & 1) << 5) | (((lane >> 5) & 1) << 8); }
constexpr int v_rd_off(int d0, int ks, int half) { return d0 * 512 + ks * 4096 + half * 2048; }
__device__ __forceinline__ int crow(int r, int hi) { return (r & 3) + 8 * (r >> 2) + 4 * hi; }
__device__ __forceinline__ bf16x8 load8(const bf16_t* p) { return *reinterpret_cast<const bf16x8*>(p); }
__device__ __forceinline__ void mask_tile(f32x16& p0, f32x16& p1, int dq, unsigned W) {
    const float NEG = -__builtin_inff();
#pragma unroll
    for (int r = 0; r < 16; ++r) {
        const int c = (r & 3) + 8 * (r >> 2);
        if ((unsigned)(dq - c) >= W) p0[r] = NEG;
        if ((unsigned)(dq - c - 32) >= W) p1[r] = NEG;
    }
}
__device__ __forceinline__ void partialSM(f32x16& p0, f32x16& p1, float& m_reg, float& mn, float& alpha) {
    float pmax = p0[0];
#pragma unroll
    for (int r = 1; r < 16; ++r) pmax = fmaxf(pmax, p0[r]);
#pragma unroll
    for (int r = 0; r < 16; ++r) pmax = fmaxf(pmax, p1[r]);
    { auto rr = __builtin_amdgcn_permlane32_swap(__float_as_uint(pmax), __float_as_uint(pmax), false, false);
      pmax = fmaxf(__uint_as_float(rr[0]), __uint_as_float(rr[1])); }
    constexpr float C2 = 1.4426950408889634f * SCALE;
    if (__builtin_expect(__all((pmax - m_reg) * SCALE <= THR), 1)) { mn = m_reg; alpha = 1.f; }
    else { mn = fmaxf(m_reg, pmax); alpha = __builtin_amdgcn_exp2f((m_reg - mn) * C2); m_reg = mn; }
    const float mnL = -mn * C2;
#pragma unroll
    for (int r = 0; r < 16; ++r) p0[r] = fmaf(p0[r], C2, mnL);
#pragma unroll
    for (int r = 0; r < 16; ++r) p1[r] = fmaf(p1[r], C2, mnL);
#pragma unroll
    for (int r = 0; r < 16; ++r) p0[r] = __builtin_amdgcn_exp2f(p0[r]);
}
__device__ __forceinline__ void finishSM(f32x16& p0, f32x16& p1, float alpha, float& l_reg, bf16x8& pa0, bf16x8& pa1, bf16x8& pa2, bf16x8& pa3) {
#pragma unroll
    for (int r = 0; r < 16; ++r) p1[r] = __builtin_amdgcn_exp2f(p1[r]);
    float ps = 0;
#pragma unroll
    for (int r = 0; r < 16; ++r) ps += p0[r];
#pragma unroll
    for (int r = 0; r < 16; ++r) ps += p1[r];
    { auto rr = __builtin_amdgcn_permlane32_swap(__float_as_uint(ps), __float_as_uint(ps), false, false);
      ps = __uint_as_float(rr[0]) + __uint_as_float(rr[1]); }
    l_reg = l_reg * alpha + ps;
#define PK4(P, B_, OUT) do { unsigned a0 = cvt_pk_bf16(P[B_+0], P[B_+1]), a1 = cvt_pk_bf16(P[B_+2], P[B_+3]);                          \
        unsigned b0 = cvt_pk_bf16(P[B_+4], P[B_+5]), b1 = cvt_pk_bf16(P[B_+6], P[B_+7]);                                             \
        auto r0 = __builtin_amdgcn_permlane32_swap(a0, b0, false, false); auto r1 = __builtin_amdgcn_permlane32_swap(a1, b1, false, false); \
        u32x4 w = {r0[0], r1[0], r0[1], r1[1]}; OUT = *reinterpret_cast<bf16x8*>(&w); } while (0)
    PK4(p0, 0, pa0); PK4(p0, 8, pa1); PK4(p1, 0, pa2); PK4(p1, 8, pa3);
#undef PK4
}
template <int KB>
__device__ __forceinline__ void qkt(f32x16& p0, f32x16& p1, const char* lds, int r32, int hi, const bf16x8* qr, const char* qrl) {
    p0 = f32x16{}; p1 = f32x16{};
    const char* kb[4]; const char* rb[4];
#pragma unroll
    for (int dd = 0; dd < 4; ++dd) { kb[dd] = lds + OFF_KN + KB * SHM_KN + KSWZ(r32, (dd * 16 + hi * 8) * 2); rb[dd] = lds + OFF_KR + KB * SHM_KR + KRSWZ(r32, (dd * 16 + hi * 8) * 2); }
#pragma unroll
    for (int d0 = 0; d0 < 8; ++d0) { const char* a = kb[d0 & 3] + (d0 >> 2) * 128;
        bf16x8 b0 = *reinterpret_cast<const bf16x8*>(a);
        bf16x8 b1 = *reinterpret_cast<const bf16x8*>(a + 32 * 256);
        p0 = __builtin_amdgcn_mfma_f32_32x32x16_bf16(b0, qr[d0], p0, 0, 0, 0);
        p1 = __builtin_amdgcn_mfma_f32_32x32x16_bf16(b1, qr[d0], p1, 0, 0, 0); }
#pragma unroll
    for (int d0 = 0; d0 < 4; ++d0) { const char* a = rb[d0];
        bf16x8 b0 = *reinterpret_cast<const bf16x8*>(a);
        bf16x8 b1 = *reinterpret_cast<const bf16x8*>(a + 32 * 128);
        const bf16x8 qf = *reinterpret_cast<const bf16x8*>(qrl + d0 * 1024);
        p0 = __builtin_amdgcn_mfma_f32_32x32x16_bf16(b0, qf, p0, 0, 0, 0);
        p1 = __builtin_amdgcn_mfma_f32_32x32x16_bf16(b1, qf, p1, 0, 0, 0); }
}
template <int VB>
__device__ __forceinline__ void pv_tile(f32x16* o, int vb0, bf16x8 pa0, bf16x8 pa1, bf16x8 pa2, bf16x8 pa3) {
#define TRRD(dst, off) asm volatile("ds_read_b64_tr_b16 %0, %1 offset:%2" : "=&v"(dst) : "v"(vb0), "i"(off) : "memory")
#define PV_D0(d0) do { s16x4 l0, l1, l2, l3, h0, h1, h2, h3; constexpr int b_ = OFF_V + VB * SHM_V + v_rd_off(d0, 0, 0); \
        TRRD(l0, b_); TRRD(h0, b_ + 2048); TRRD(l1, b_ + 4096); TRRD(h1, b_ + 6144); TRRD(l2, b_ + 8192); TRRD(h2, b_ + 10240); TRRD(l3, b_ + 12288); TRRD(h3, b_ + 14336); \
        asm volatile("s_waitcnt lgkmcnt(0)" ::: "memory"); SBAR();   \
        o[d0] = __builtin_amdgcn_mfma_f32_32x32x16_bf16(pa0, (bf16x8){l0[0], l0[1], l0[2], l0[3], h0[0], h0[1], h0[2], h0[3]}, o[d0], 0, 0, 0);   \
        o[d0] = __builtin_amdgcn_mfma_f32_32x32x16_bf16(pa1, (bf16x8){l1[0], l1[1], l1[2], l1[3], h1[0], h1[1], h1[2], h1[3]}, o[d0], 0, 0, 0);   \
        o[d0] = __builtin_amdgcn_mfma_f32_32x32x16_bf16(pa2, (bf16x8){l2[0], l2[1], l2[2], l2[3], h2[0], h2[1], h2[2], h2[3]}, o[d0], 0, 0, 0);   \
        o[d0] = __builtin_amdgcn_mfma_f32_32x32x16_bf16(pa3, (bf16x8){l3[0], l3[1], l3[2], l3[3], h3[0], h3[1], h3[2], h3[3]}, o[d0], 0, 0, 0); } while (0)
    PV_D0(0); PV_D0(1); PV_D0(2); PV_D0(3);
#undef PV_D0
#undef TRRD
}
struct BlockRef { const bf16_t* Qn; const bf16_t* Qr; const bf16_t* Kn; const bf16_t* Kr; const bf16_t* V; bf16_t* O; int P0; };
struct Seam { bf16x8 qr[8]; bf16x8 st_v0, st_v1, st_k0, st_k1, st_kr; };
#define VMW() asm volatile("s_waitcnt vmcnt(0)" ::: "memory")
#define VMWN(n) asm volatile("s_waitcnt vmcnt(%0)" :: "i"(n) : "memory")
#define UB(p) ((const char*)(p))
#define UNI(p) uni_ptr((const void*)(p))
#define SLOAD_H(R, k0) do { const char* vb_ = UNI((R).V + (size_t)(k0) * LV); const char* kb_ = UNI((R).Kn + (size_t)(k0) * LKN); const char* rb_ = UNI((R).Kr + (size_t)(k0) * LKR); \
                            S.st_v0 = *(const bf16x8*)(vb_ + voffA); S.st_v1 = *(const bf16x8*)(vb_ + voffB); \
                            S.st_k0 = *(const bf16x8*)(kb_ + voffA); S.st_k1 = *(const bf16x8*)(kb_ + voffB); \
                            S.st_kr = *(const bf16x8*)(rb_ + voffR); } while (0)
#define SWRITE_HK(bf) do { *(bf16x8*)(lds + OFF_KN + (bf) * SHM_KN + kws) = S.st_k0; *(bf16x8*)(lds + OFF_KN + (bf) * SHM_KN + kws + 32 * 256) = S.st_k1; \
                           *(bf16x8*)(lds + OFF_KR + (bf) * SHM_KR + krws) = S.st_kr; } while (0)
#define SWRITE_HV(bf) do { *(bf16x8*)(lds + OFF_V + (bf) * SHM_V + vst0) = S.st_v0; *(bf16x8*)(lds + OFF_V + (bf) * SHM_V + vst1) = S.st_v1; } while (0)
#define SWRITE_H(bf) do { SWRITE_HV(bf); SWRITE_HK(bf); } while (0)
#define QLOAD(R) do { _Pragma("unroll") for (int d0 = 0; d0 < 8; ++d0) S.qr[d0] = *(const bf16x8*)(UB((R).Qn) + voffQ + d0 * 32); } while (0)
__device__ __forceinline__ void block(const BlockRef& cur, char* lds) {
    const int tid = opaque_tid(), wid = __builtin_amdgcn_readfirstlane(tid >> 6), lane = tid & 63, r32 = lane & 31, hi = lane >> 5;
    constexpr int W = 1 << 30;
    const int NT = (cur.P0 + QB - 1) / KVBLK + 1;
    const int qlo = cur.P0 + wid * QBLK, qm = qlo + r32 - 4 * hi;
    float* ws = (float*)(lds + OFF_WS) + wid * 64; float* li_l = ws, * al_l = ws + 32;
    float m_reg = -1e30f, l_reg = 0; f32x16 o[4] = {};
    const int sr = tid >> 4, sc = (tid & 15) * 8, vst0 = v_st(sr, sc), vst1 = v_st(32 + sr, sc), kws = KSWZ(sr, sc * 2);
    const int kr_r = tid >> 3, kr_c = (tid & 7) * 8, krws = KRSWZ(kr_r, kr_c * 2);
    const int vb0 = (int)(uintptr_t)lds + v_rd_base(lane);
    char* qrl = lds + OFF_QR + wid * 4096 + lane * 16;
    const unsigned voffA = (unsigned)(sr * LV + sc) * 2u, voffB = voffA + 32u * LV * 2u, voffR = (unsigned)(kr_r * LKR + kr_c) * 2u;
    const unsigned voffQ = (unsigned)((wid * QBLK + r32) * LQN + hi * 8) * 2u, voffQr = (unsigned)((wid * QBLK + r32) * LQR + hi * 8) * 2u;
    Seam S;
    { bf16x8 tq[4];
#pragma unroll
      for (int d0 = 0; d0 < 4; ++d0) tq[d0] = *(const bf16x8*)(UB(cur.Qr) + voffQr + d0 * 32);
      QLOAD(cur);
      SLOAD_H(cur, 0);
#pragma unroll
      for (int d0 = 0; d0 < 4; ++d0) *reinterpret_cast<bf16x8*>(qrl + d0 * 1024) = tq[d0]; }
    VMW(); SWRITE_H(0);
    __syncthreads();
#define RESC(a) do { if (__any((a) < 1.f)) { if (hi == 0) al_l[r32] = (a); asm volatile("s_waitcnt lgkmcnt(0)" ::: "memory");              \
                     _Pragma("unroll") for (int d_ = 0; d_ < 4; ++d_) _Pragma("unroll") for (int r = 0; r < 16; ++r) o[d_][r] *= al_l[crow(r, hi)]; } } while (0)
#define KBASE(t) ((t) * KVBLK)
#define MASKT(P0_, P1_, t) do { const int kb_ = KBASE(t); if (kb_ + KVBLK - 1 > qlo) mask_tile(P0_, P1_, qm - kb_, (unsigned)W); } while (0)
    f32x16 pA0, pA1, pB0, pB1; float mnA, mnB, alA, alB; bf16x8 pa0, pa1, pa2, pa3;
    if (NT > 1) { SLOAD_H(cur, KBASE(1)); }
    SBAR(); qkt<0>(pA0, pA1, lds, r32, hi, S.qr, qrl);
    MASKT(pA0, pA1, 0); partialSM(pA0, pA1, m_reg, mnA, alA);
    if (NT > 1) { VMW(); SWRITE_H(1); }
    __syncthreads();
#define HALF_STEP(PX0, PX1, mnX, alX, PY0, PY1, alY, t, KB, VB, SB) do {                                                      \
        SBAR(); qkt<KB>(PX0, PX1, lds, r32, hi, S.qr, qrl);                                             \
        finishSM(PY0, PY1, alY, l_reg, pa0, pa1, pa2, pa3); SBAR();                                                           \
        if ((t) + 1 < NT) { SLOAD_H(cur, KBASE((t) + 1)); SBAR(); }                                               \
        pv_tile<VB>(o, vb0, pa0, pa1, pa2, pa3); MASKT(PX0, PX1, (t)); partialSM(PX0, PX1, m_reg, mnX, alX);                                        \
        __syncthreads();                                                                                                      \
        if ((t) + 1 < NT) { VMW(); SWRITE_H(SB); }                                                                          \
        RESC(alX); __syncthreads(); } while (0)
    for (int t = 1; t + 1 < NT; t += 2) {
        HALF_STEP(pB0, pB1, mnB, alB, pA0, pA1, alA, t, 1, 0, 0);
        HALF_STEP(pA0, pA1, mnA, alA, pB0, pB1, alB, t + 1, 0, 1, 1);
    }
    const bool even = (NT & 1) == 0;
    if (even) { SBAR(); qkt<1>(pB0, pB1, lds, r32, hi, S.qr, qrl); SBAR(); }
    finishSM(pA0, pA1, alA, l_reg, pa0, pa1, pa2, pa3); SBAR();
    pv_tile<0>(o, vb0, pa0, pa1, pa2, pa3);
    if (even) { MASKT(pB0, pB1, NT - 1); partialSM(pB0, pB1, m_reg, mnB, alB); __syncthreads(); RESC(alB);
        finishSM(pB0, pB1, alB, l_reg, pa0, pa1, pa2, pa3); SBAR(); pv_tile<1>(o, vb0, pa0, pa1, pa2, pa3); }
    SBAR();
    if (hi == 0) li_l[r32] = l_reg; asm volatile("s_waitcnt lgkmcnt(0)" ::: "memory");
    float rli[16];
#pragma unroll
    for (int r = 0; r < 16; ++r) rli[r] = __builtin_amdgcn_rcpf(li_l[crow(r, hi)]);
    const unsigned voffO = (unsigned)((wid * QBLK + 4 * hi) * LO + r32) * 2u;
#pragma unroll
    for (int r = 0; r < 16; ++r) { const int orow8 = (r & 3) + 8 * (r >> 2);
#pragma unroll
        for (int d0 = 0; d0 < 4; ++d0) { const float v = o[d0][r] * rli[r];
            const float vn = __shfl_xor(v, 1);
            if ((r32 & 1) == 0) *(unsigned*)((char*)cur.O + voffO + (orow8 * LO + d0 * 32) * 2) = cvt_pk_bf16(v, vn); } }
    __syncthreads();
#undef RESC
#undef KBASE
#undef MASKT
#undef HALF_STEP
}
#undef VMW
#undef VMWN
#undef SLOAD_H
#undef UB
#undef UNI
#undef SWRITE_HK
#undef SWRITE_HV
#undef SWRITE_H
#undef QLOAD
__device__ __forceinline__ BlockRef make_ref(int bh, int qb, const bf16_t* QN, const bf16_t* QR, const bf16_t* KN, const bf16_t* KR, const bf16_t* V, bf16_t* O) {
    const int b = bh >> 3, h = bh & 7; const size_t rb = (size_t)b * SEQ, q0 = rb + (size_t)qb * QB;
    BlockRef r; r.Qn = QN + q0 * LQN + h * 128; r.Qr = QR + q0 * LQR + h * 64; r.Kn = KN + rb * LKN + h * 128; r.Kr = KR + rb * LKR; r.V = V + rb * LV + h * 128;
    r.O = O + q0 * LO + h * 128; r.P0 = qb * QB; return r;
}
__device__ __forceinline__ void phase(char* lds, int vcu, int G, const bf16_t* QN, const bf16_t* QR, const bf16_t* KN, const bf16_t* KR, const bf16_t* V, bf16_t* O) {
    constexpr int NITEM = BATCH * 8 * 16;
    for (int L = vcu; L < NITEM; L += G) {
#pragma unroll 1
        for (int pass = 0; pass < 2; ++pass) {
            const int qb = pass == 0 ? (L & 15) : 31 - (L & 15);
            const BlockRef cur = make_ref(L >> 4, qb, QN, QR, KN, KR, V, O);
            block(cur, lds);
        }
    }
}
#undef KSWZ
#undef KRSWZ
#undef SBAR
}

namespace swa {
constexpr int K_OFF = 0, VT_OFF = 32768, VT_PITCH = 544, POS_OFF = VT_OFF + 64 * VT_PITCH, LDS_BYTES = POS_OFF + 1024;
__device__ __forceinline__ void unit(int u, const bf16_t* QA, const bf16_t* KA, const bf16_t* VA, bf16_t* AA, const int* pos, const float* sinks, char* lds) {
    const int tid = opaque_tid(), lane = tid & 63, wid = __builtin_amdgcn_readfirstlane(tid >> 6), r16 = lane & 15, g4 = lane >> 4;
    const int b = u >> 8, n = (u & 255) >> 2, kvh = u & 3;
    const int rowbase = b * SEQ, qrow0 = rowbase + n * 128, krow0 = qrow0 - 128;
    __syncthreads();
#pragma unroll
    for (int i = 0; i < 4; ++i) { const int id = tid + 512 * i, key = id >> 3, ch = id & 7; const bool valid = (n > 0) || (key >= 128);
        unsigned z_ = 0u; asm volatile("" : "+v"(z_)); u32x4 kv = {z_, z_, z_, z_}, vv = {z_, z_, z_, z_};
        if (valid) { kv = *(const u32x4*)(KA + (size_t)(krow0 + key) * 256 + kvh * 64 + ch * 8); vv = *(const u32x4*)(VA + (size_t)(krow0 + key) * 256 + kvh * 64 + ch * 8); }
        *(u32x4*)(lds + K_OFF + key * 128 + ((ch ^ (key & 7)) << 4)) = kv;
#pragma unroll
        for (int j = 0; j < 4; ++j) { *(unsigned short*)(lds + VT_OFF + (ch * 8 + 2 * j) * VT_PITCH + key * 2) = (unsigned short)(vv[j] & 0xffffu);
                                      *(unsigned short*)(lds + VT_OFF + (ch * 8 + 2 * j + 1) * VT_PITCH + key * 2) = (unsigned short)(vv[j] >> 16); } }
    if (tid < 256) { int kidx = krow0 + tid; if (kidx < rowbase) kidx = rowbase; *(float*)(lds + POS_OFF + tid * 4) = (float)pos[kidx]; }
    if (tid < 128) { unsigned z_ = 0u; asm volatile("" : "+v"(z_)); *(u32x4*)(lds + VT_OFF + (tid >> 1) * VT_PITCH + 512 + (tid & 1) * 16) = (u32x4){z_, z_, z_, z_}; }
    __syncthreads();
    const int qt = wid, qi = 16 * qt + r16;
    const float pqf = (float)pos[qrow0 + qi];
    const char* kb0 = lds + K_OFF + qt * 2048 + r16 * 128 + ((g4 ^ (r16 & 7)) << 4);
    const char* kb1 = lds + K_OFF + qt * 2048 + r16 * 128 + (((g4 + 4) ^ (r16 & 7)) << 4);
    const char* vb = lds + VT_OFF + r16 * VT_PITCH + (qt * 16 + 4 * g4) * 2;
    const char* pb = lds + POS_OFF + (qt * 16 + 4 * g4) * 4;
    const int relb = 128 + qi - (qt * 16 + 4 * g4);
    const int kjb = qt * 16 + 4 * g4;
    float dm[9][4];
#pragma unroll
    for (int i = 0; i < 9; ++i) { const f32x4 pk = *(const f32x4*)(pb + i * 64);
#pragma unroll
        for (int rg = 0; rg < 4; ++rg) { const int rel = relb - 16 * i - rg; const bool v = ((unsigned)rel < 128u) && (n > 0 || kjb + 16 * i + rg >= 128); dm[i][rg] = v ? fabsf(pqf - pk[rg]) : 1e30f; } }
    constexpr float L2E = 1.4426950408889634f;
#pragma unroll 1
    for (int g = 0; g < 4; ++g) {
        const int h = kvh * 4 + g;
        const float nslope = -L2E * exp2f(-0.5f * (float)(h + 1)), sink = sinks[h] * L2E;
        const bf16_t* qp = QA + (size_t)(qrow0 + qi) * 1024 + h * 64 + 8 * g4;
        const bf16x8 bq0 = *(const bf16x8*)qp, bq1 = *(const bf16x8*)(qp + 32);
        f32x4 s[10]; float mx = -1e30f;
#pragma unroll
        for (int i = 0; i < 9; ++i) {
            const bf16x8 a0 = *(const bf16x8*)(kb0 + i * 2048), a1 = *(const bf16x8*)(kb1 + i * 2048);
            f32x4 c = {0.f, 0.f, 0.f, 0.f};
            c = __builtin_amdgcn_mfma_f32_16x16x32_bf16(a0, bq0, c, 0, 0, 0);
            c = __builtin_amdgcn_mfma_f32_16x16x32_bf16(a1, bq1, c, 0, 0, 0);
#pragma unroll
            for (int rg = 0; rg < 4; ++rg) { const float lg = fmaf(c[rg], 0.125f * L2E, nslope * dm[i][rg]); c[rg] = lg; mx = fmaxf(mx, lg); }
            s[i] = c;
            if (i % 3 == 2) __builtin_amdgcn_sched_barrier(0);
        }
        s[9] = (f32x4){0.f, 0.f, 0.f, 0.f};
        mx = fmaxf(mx, __shfl_xor(mx, 16)); mx = fmaxf(mx, __shfl_xor(mx, 32)); mx = fmaxf(mx, sink);
        float sum = 0.f;
#pragma unroll
        for (int i = 0; i < 9; ++i)
#pragma unroll
            for (int rg = 0; rg < 4; ++rg) { const float p = __builtin_amdgcn_exp2f(s[i][rg] - mx); s[i][rg] = p; sum += p; }
        sum += __shfl_xor(sum, 16); sum += __shfl_xor(sum, 32);
        const float inv = 1.f / (sum + __builtin_amdgcn_exp2f(sink - mx));
        bf16x8 bp[5];
#pragma unroll
        for (int ks = 0; ks < 5; ++ks) bp[ks] = pack8(s[2 * ks] * inv, s[2 * ks + 1] * inv);
        __builtin_amdgcn_sched_barrier(0);
#pragma unroll
        for (int dt = 0; dt < 4; ++dt) { f32x4 o = {0.f, 0.f, 0.f, 0.f};
#pragma unroll
            for (int ks = 0; ks < 5; ++ks) {
                const u32x2 lo = *(const u32x2*)(vb + dt * 16 * VT_PITCH + ks * 64), hi2 = *(const u32x2*)(vb + dt * 16 * VT_PITCH + ks * 64 + 32);
                const u32x4 aw = {lo[0], lo[1], hi2[0], hi2[1]};
                o = __builtin_amdgcn_mfma_f32_16x16x32_bf16(__builtin_bit_cast(bf16x8, aw), bp[ks], o, 0, 0, 0); }
            u32x2 ow = {cvt_pk_bf16(o[0], o[1]), cvt_pk_bf16(o[2], o[3])};
            *(u32x2*)(AA + (size_t)(qrow0 + qi) * 1024 + h * 64 + dt * 16 + 4 * g4) = ow;
            __builtin_amdgcn_sched_barrier(0); }
    }
}
}

__device__ __forceinline__ void transpose_item_f8(const float* W, int K, int N, unsigned char* WT, int dst_row0, int src_col0, int k0, float scale, LAS float* scr, int lane) {
#pragma unroll 8
    for (int i = 0; i < 32; ++i) { const int kk = 2 * i + (lane >> 5); scr[kk * 33 + (lane & 31)] = W[(size_t)(k0 + kk) * N + src_col0 + (lane & 31)] * scale; }
    asm volatile("s_waitcnt lgkmcnt(0)" ::: "memory");
    const int c = lane & 7;
#pragma unroll
    for (int j = 0; j < 4; ++j) { const int n = (lane >> 3) + 8 * j; const LAS float* sp = scr + (8 * c) * 33 + n;
        int p0 = 0, p1 = 0;
        p0 = __builtin_amdgcn_cvt_pk_fp8_f32(sp[0 * 33], sp[1 * 33], p0, false); p0 = __builtin_amdgcn_cvt_pk_fp8_f32(sp[2 * 33], sp[3 * 33], p0, true);
        p1 = __builtin_amdgcn_cvt_pk_fp8_f32(sp[4 * 33], sp[5 * 33], p1, false); p1 = __builtin_amdgcn_cvt_pk_fp8_f32(sp[6 * 33], sp[7 * 33], p1, true);
        *(u32x2*)(WT + (size_t)(dst_row0 + n) * K + k0 + 8 * c) = (u32x2){(unsigned)p0, (unsigned)p1}; }
    asm volatile("s_waitcnt lgkmcnt(0)" ::: "memory");
}
__device__ __forceinline__ void transpose_item(const float* W, int K, int N, bf16_t* WT, int dst_row0, int src_col0, int k0, const float* gk, LAS float* scr, int lane) {
    if (src_col0 < 0) {
        const int c = lane & 7;
#pragma unroll
        for (int j = 0; j < 4; ++j) { const int n = (lane >> 3) + 8 * j; *(u32x4*)(WT + (size_t)(dst_row0 + n) * K + k0 + 8 * c) = (u32x4){0u, 0u, 0u, 0u}; }
        return;
    }
#pragma unroll 8
    for (int i = 0; i < 32; ++i) { const int kk = 2 * i + (lane >> 5); float v = W[(size_t)(k0 + kk) * N + src_col0 + (lane & 31)]; if (gk) v *= gk[k0 + kk]; scr[kk * 33 + (lane & 31)] = v; }
    asm volatile("s_waitcnt lgkmcnt(0)" ::: "memory");
    const int c = lane & 7;
#pragma unroll
    for (int j = 0; j < 4; ++j) { const int n = (lane >> 3) + 8 * j; const LAS float* s = scr + (8 * c) * 33 + n;
        u32x4 o; o.x = cvt_pk_bf16(s[0 * 33], s[1 * 33]); o.y = cvt_pk_bf16(s[2 * 33], s[3 * 33]); o.z = cvt_pk_bf16(s[4 * 33], s[5 * 33]); o.w = cvt_pk_bf16(s[6 * 33], s[7 * 33]);
        *(u32x4*)(WT + (size_t)(dst_row0 + n) * K + k0 + 8 * c) = o; }
    asm volatile("s_waitcnt lgkmcnt(0)" ::: "memory");
}
__device__ __forceinline__ int win_src(int r0) {
    if (r0 < 2304) return r0;
    if (r0 < 2560) { const int c = r0 - 2304; return c == 0 ? 2304 : (c == 128 ? 2336 : -1); }
    return 2368 + (r0 - 2560);
}
__device__ __forceinline__ int wuq_src(int r0) {
    if (r0 < 1024) return (r0 >> 7) * 192 + (r0 & 127);
    const int rp = r0 - 1024, t = rp >> 8, c = rp & 255, bj = c >> 7, within = c & 127;
    return (4 * t + (within >> 5)) * 192 + 128 + bj * 32;
}
__device__ __forceinline__ void rms_row_bf16(const float* xrow, const float* g, bf16_t* orow, int lane) {
    f32x4 v[8]; float s = 0.f;
#pragma unroll
    for (int j = 0; j < 8; ++j) { v[j] = *(const f32x4*)(xrow + 256 * j + 4 * lane); s += (v[j][0] * v[j][0] + v[j][1] * v[j][1]) + (v[j][2] * v[j][2] + v[j][3] * v[j][3]); }
    const float rstd = rsqrtf(wave_sum(s) * (1.f / DM) + EPS);
#pragma unroll
    for (int j = 0; j < 8; ++j) { const f32x4 gg = *(const f32x4*)(g + 256 * j + 4 * lane); const f32x4 o = v[j] * rstd * gg;
        u32x2 w = {cvt_pk_bf16(o[0], o[1]), cvt_pk_bf16(o[2], o[3])}; *(u32x2*)(orow + 256 * j + 4 * lane) = w; }
}
template <int NR>
__device__ __forceinline__ void rms_rows_bf16(const float* xbase, const bf16_t* ybase  , const float* g, bf16_t* obase, int m0, int mstride, int lane,
                                              unsigned char* xq = nullptr  , float* sx = nullptr  ,
                                              unsigned char* h8 = nullptr  ) {
    f32x4 v[NR][8];
#pragma unroll
    for (int r = 0; r < NR; ++r)
#pragma unroll
        for (int j = 0; j < 8; ++j) v[r][j] = *(const f32x4*)(xbase + (size_t)(m0 + r * mstride) * DM + 256 * j + 4 * lane);
    if (ybase) {
        u32x2 yv[NR][8];
#pragma unroll
        for (int r = 0; r < NR; ++r)
#pragma unroll
            for (int j = 0; j < 8; ++j) yv[r][j] = *(const u32x2*)(ybase + (size_t)(m0 + r * mstride) * DM + 256 * j + 4 * lane);
#pragma unroll
        for (int r = 0; r < NR; ++r)
#pragma unroll
            for (int j = 0; j < 8; ++j) { v[r][j][0] += bf_lo(yv[r][j][0]); v[r][j][1] += bf_hi(yv[r][j][0]); v[r][j][2] += bf_lo(yv[r][j][1]); v[r][j][3] += bf_hi(yv[r][j][1]); }
    }
#pragma unroll
    for (int r = 0; r < NR; ++r) { float s = 0.f;
        f32x4 gg[8];
        { const float* gp = g + 4 * lane; asm volatile("" : "+v"(gp));
#pragma unroll
          for (int j = 0; j < 8; ++j) gg[j] = *(const f32x4*)(gp + 256 * j); }
#pragma unroll
        for (int j = 0; j < 8; ++j) s += (v[r][j][0] * v[r][j][0] + v[r][j][1] * v[r][j][1]) + (v[r][j][2] * v[r][j][2] + v[r][j][3] * v[r][j][3]);
        const float rstd = rsqrtf(wave_sum(s) * (1.f / DM) + EPS);
        bf16_t* orow = obase + (size_t)(m0 + r * mstride) * DM;
#pragma unroll
        for (int j = 0; j < 8; ++j) { const f32x4 o = v[r][j] * rstd * gg[j]; v[r][j] = o; u32x2 w = {cvt_pk_bf16(o[0], o[1]), cvt_pk_bf16(o[2], o[3])}; *(u32x2*)(orow + 256 * j + 4 * lane) = w; }
        if (h8) { unsigned char* hrow = h8 + (size_t)(m0 + r * mstride) * DM;
#pragma unroll
            for (int j = 0; j < 8; ++j) { const f32x4 y = v[r][j] * H8_SCALE; int p = 0; p = __builtin_amdgcn_cvt_pk_fp8_f32(y[0], y[1], p, false); p = __builtin_amdgcn_cvt_pk_fp8_f32(y[2], y[3], p, true);
                *(unsigned*)(hrow + 256 * j + 4 * lane) = (unsigned)p; } }
        if (xq) { float mx = 0.f;
#pragma unroll
            for (int j = 0; j < 8; ++j) mx = fmaxf(mx, fmaxf(fmaxf(fabsf(v[r][j][0]), fabsf(v[r][j][1])), fmaxf(fabsf(v[r][j][2]), fabsf(v[r][j][3]))));
#pragma unroll
            for (int o = 1; o < 64; o <<= 1) mx = fmaxf(mx, __shfl_xor(mx, o));
            const float sc = mx > 0.f ? 127.f / mx : 0.f;
            unsigned char* qrow = xq + (size_t)(m0 + r * mstride) * DM;
#pragma unroll
            for (int j = 0; j < 8; ++j) *(unsigned*)(qrow + 256 * j + 4 * lane) = pack_i8x4(v[r][j] * sc);
            if (lane == 0) sx[m0 + r * mstride] = mx * (1.f / 127.f); } }
}
__device__ __forceinline__ void fold_unit(int u, const float* wq, const float* keys, bf16_t* WPK, int lane, int wid) {
    const int hp = u >> 4, k0 = (u & 15) * 128, r16 = lane & 15, g4 = lane >> 4;
    bf16x8 A[4];
#pragma unroll
    for (int s = 0; s < 4; ++s) { const float* p = wq + (size_t)(k0 + wid * 16 + r16) * 2048 + hp * 128 + 8 * g4 + 32 * s; A[s] = pack8(*(const f32x4*)p, *(const f32x4*)(p + 4)); }
#pragma unroll 2
    for (int nt = 0; nt < 8; ++nt) { f32x4 c = {0.f, 0.f, 0.f, 0.f};
#pragma unroll
        for (int s = 0; s < 4; ++s) { const float* p = keys + (size_t)(hp * 128 + nt * 16 + r16) * 128 + 8 * g4 + 32 * s;
            c = __builtin_amdgcn_mfma_f32_16x16x32_bf16(A[s], pack8(*(const f32x4*)p, *(const f32x4*)(p + 4)), c, 0, 0, 0); }
        u32x2 w = {cvt_pk_bf16(c[0], c[1]), cvt_pk_bf16(c[2], c[3])};
        *(u32x2*)(WPK + (size_t)(hp * 128 + nt * 16 + r16) * 2048 + k0 + wid * 16 + 4 * g4) = w; }
}

__device__ __forceinline__ void ins16(float (&l)[16], float x) {
#pragma unroll
    for (int k = 15; k >= 1; --k) l[k] = __builtin_amdgcn_fmed3f(l[k - 1], l[k], x);
    l[0] = fmaxf(l[0], x);
}
__device__ __forceinline__ void topk_item(int item, const float* SC, int* RI, float* RG) {
    const int t = item >> 3, h = item & 7;
    const float* srow = SC + (size_t)t * 2048 + h * 256;
    float la[16], lb[16];
#pragma unroll
    for (int k = 0; k < 16; ++k) { la[k] = -__builtin_inff(); lb[k] = -__builtin_inff(); }
#pragma unroll 1
    for (int c = 0; c < 8; ++c) {
        f32x4 va[4], vb[4];
#pragma unroll
        for (int j = 0; j < 4; ++j) { va[j] = *(const f32x4*)(srow + c * 16 + j * 4); vb[j] = *(const f32x4*)(srow + 128 + c * 16 + j * 4); }
#pragma unroll
        for (int j = 0; j < 4; ++j)
#pragma unroll
            for (int e = 0; e < 4; ++e) { const unsigned tag = 127u - (unsigned)(c * 16 + j * 4 + e);
                ins16(la, __uint_as_float((__float_as_uint(va[j][e]) & ~0x7fu) | tag));
                ins16(lb, __uint_as_float((__float_as_uint(vb[j][e]) & ~0x7fu) | tag)); }
    }
    float av[16], bv[16]; int ai[16], bi[16];
#pragma unroll
    for (int k = 0; k < 16; ++k) { const unsigned ua = __float_as_uint(la[k]), ub = __float_as_uint(lb[k]);
        av[k] = __uint_as_float(ua & ~0x7fu); bv[k] = __uint_as_float(ub & ~0x7fu); ai[k] = 127 - (int)(ua & 0x7fu); bi[k] = 127 - (int)(ub & 0x7fu); }
    float lc[16];
#pragma unroll
    for (int k = 0; k < 16; ++k) lc[k] = -__builtin_inff();
#pragma unroll
    for (int i = 0; i < 16; ++i)
#pragma unroll
        for (int j = 0; j < 16; ++j) if ((i + 1) * (j + 1) <= 16) {
            const float sm = av[i] + bv[j]; ins16(lc, __uint_as_float((__float_as_uint(sm) & ~0xffu) | (255u - (unsigned)(i * 16 + j)))); }
    const float thr = lc[15], mxs = __uint_as_float(__float_as_uint(lc[0]) & ~0xffu);
    int cnt = 0; float gsum = 0.f; int* ri = RI + (size_t)t * 128 + h * 16; float* rg = RG + (size_t)t * 128 + h * 16;
#pragma unroll
    for (int i = 0; i < 16; ++i)
#pragma unroll
        for (int j = 0; j < 16; ++j) if ((i + 1) * (j + 1) <= 16) {
            const float sm = av[i] + bv[j]; const float key = __uint_as_float((__float_as_uint(sm) & ~0xffu) | (255u - (unsigned)(i * 16 + j)));
            if (key >= thr && cnt < 16) { const float ev = __expf(sm - mxs); ri[cnt] = (ai[i] * 128 + bi[j]) & 16383; rg[cnt] = ev; gsum += ev; ++cnt; } }
    for (; cnt < 16; ++cnt) { ri[cnt] = 0; rg[cnt] = 0.f; }
    const float ginv = gsum > 0.f ? 1.f / gsum : 0.f;
#pragma unroll
    for (int k = 0; k < 16; ++k) rg[k] *= ginv;
}

typedef float f32x2 __attribute__((ext_vector_type(2)));
#define DPP_ADD(v, CTRL) ((v) + __builtin_bit_cast(float, __builtin_amdgcn_update_dpp(0, __builtin_bit_cast(int, (v)), (CTRL), 0xF, 0xF, true)))
#define DPP_GET(v, CTRL) (__builtin_bit_cast(float, __builtin_amdgcn_update_dpp(0, __builtin_bit_cast(int, (v)), (CTRL), 0xF, 0xF, true)))
__device__ __forceinline__ float gelu_erf(float a) { return 0.5f * a * (1.f + erff(a * 0.70710678118654752f)); }
__device__ __forceinline__ void fp8_row_load(const float* src, f32x4 (&v)[8], int lane) {
#pragma unroll
    for (int q = 0; q < 8; ++q) v[q] = *(const f32x4*)(src + q * 256 + lane * 4);
}
__device__ __forceinline__ void i8_row_store(const f32x4 (&v)[8], unsigned char* tbl, int e, float* scale_out, int lane) {
    float mx = 0.f;
#pragma unroll
    for (int q = 0; q < 8; ++q) mx = fmaxf(mx, fmaxf(fmaxf(fabsf(v[q][0]), fabsf(v[q][1])), fmaxf(fabsf(v[q][2]), fabsf(v[q][3]))));
#pragma unroll
    for (int o = 1; o < 64; o <<= 1) mx = fmaxf(mx, __shfl_xor(mx, o));
    const float sc = mx > 0.f ? 127.f / mx : 0.f;
#pragma unroll
    for (int q = 0; q < 8; ++q) *(unsigned*)(tbl + ((size_t)(2 * q + (lane >> 5)) * 16384 + e) * 128 + (lane & 31) * 4) = pack_i8x4(v[q] * sc);
    if (lane == 0) *scale_out = mx * (1.f / 127.f);
}
__device__ __forceinline__ void fp8_row_store(const f32x4 (&v)[8], unsigned char* tbl, int e, float* scale_out, int lane) {
    float mx = 0.f;
#pragma unroll
    for (int q = 0; q < 8; ++q) mx = fmaxf(mx, fmaxf(fmaxf(fabsf(v[q][0]), fabsf(v[q][1])), fmaxf(fabsf(v[q][2]), fabsf(v[q][3]))));
#pragma unroll
    for (int o = 1; o < 64; o <<= 1) mx = fmaxf(mx, __shfl_xor(mx, o));
    int ex = 7; if (mx > 0.f) (void)frexpf(mx, &ex);
    const float sc = ldexpf(1.f, 7 - ex);
#pragma unroll
    for (int q = 0; q < 8; ++q) { int p = 0; p = __builtin_amdgcn_cvt_pk_fp8_f32(v[q][0] * sc, v[q][1] * sc, p, false); p = __builtin_amdgcn_cvt_pk_fp8_f32(v[q][2] * sc, v[q][3] * sc, p, true);
        *(unsigned*)(tbl + ((size_t)(2 * q + (lane >> 5)) * 16384 + e) * 128 + (lane & 31) * 4) = (unsigned)p; }
    if (lane == 0) *scale_out = ldexpf(1.f, ex - 7);
}
__device__ __forceinline__ void peer_u_sweep(int sl, int t0, int ts, const unsigned char* XQ, const unsigned char* PU8, const int* RI, float* AP, int lane) {
    const int l8 = lane & 7, grp = lane >> 3;
    const unsigned char* tb = PU8 + (size_t)sl * (16384 * 128) + l8 * 16;
    const unsigned char* hb = XQ + sl * 128 + l8 * 16;
    float* apb = AP + (size_t)sl * T * 128 + 64 * (l8 >> 2) + 16 * (l8 & 3) + grp;
#define U_ROUTE(EA, EB, H0, H1, TT) do { EA = RI[(size_t)(TT) * 128 + lane] & 16383; EB = RI[(size_t)(TT) * 128 + 64 + lane] & 16383; \
        H0 = *(const u32x4*)(hb + (size_t)(TT) * 2048); } while (0)
#define U_ISSUE(W, EA, EB) do { _Pragma("unroll") for (int it = 0; it < 16; ++it) { const int e_ = __shfl(it < 8 ? EA : EB, (it & 7) * 8 + grp); W[it] = *(const u32x4*)(tb + (size_t)e_ * 128); } } while (0)
#define U_COMPUTE(W, H0, H1, TT) do { \
        float r_[16]; \
        _Pragma("unroll") for (int it = 0; it < 16; ++it) { int a_ = 0; \
            _Pragma("unroll") for (int d = 0; d < 4; ++d) a_ = __builtin_amdgcn_sdot4((int)W[it][d], (int)H0[d], a_, false);     \
            r_[it] = (float)a_; } \
          \
        float s8_[8], s4_[4], s2_[2]; \
        _Pragma("unroll") for (int k = 0; k < 8; ++k) { const float kp = ub2 ? r_[k + 8] : r_[k], sd = ub2 ? r_[k] : r_[k + 8]; s8_[k] = kp + DPP_GET(sd, 0x141); } \
        _Pragma("unroll") for (int k = 0; k < 4; ++k) { const float kp = ub1 ? s8_[k + 4] : s8_[k], sd = ub1 ? s8_[k] : s8_[k + 4]; s4_[k] = kp + DPP_GET(sd, 0x4E); } \
        _Pragma("unroll") for (int k = 0; k < 2; ++k) { const float kp = ub0 ? s4_[k + 2] : s4_[k], sd = ub0 ? s4_[k] : s4_[k + 2]; s2_[k] = kp + DPP_GET(sd, 0xB1); } \
        float* ap = apb + (size_t)(TT) * 128; ap[0] = s2_[0]; ap[8] = s2_[1]; } while (0)
    const bool ub2 = (l8 & 4) != 0, ub1 = (l8 & 2) != 0, ub0 = (l8 & 1) != 0;
    int t = t0; if (t >= T) return;
    u32x4 wA[16], wB[16]; int eaA, ebA, eaB = 0, ebB = 0, eaN = 0, ebN = 0; u32x4 hA0, hA1, hB0 = {0u, 0u, 0u, 0u}, hB1 = hB0, hN0 = hB0, hN1 = hB0;
    U_ROUTE(eaA, ebA, hA0, hA1, t);
    U_ISSUE(wA, eaA, ebA);
    if (t + ts < T) U_ROUTE(eaB, ebB, hB0, hB1, t + ts);
    for (;;) {
        const bool hasB = t + ts < T, hasA2 = t + 2 * ts < T, hasB2 = t + 3 * ts < T;
        if (hasB) U_ISSUE(wB, eaB, ebB);
        if (hasA2) U_ROUTE(eaN, ebN, hN0, hN1, t + 2 * ts);
        __builtin_amdgcn_sched_barrier(0);
        U_COMPUTE(wA, hA0, hA1, t);
        if (!hasB) break;
        __builtin_amdgcn_sched_barrier(0);
        if (hasA2) U_ISSUE(wA, eaN, ebN);
        hA0 = hN0; hA1 = hN1;
        u32x4 hX0 = hB0, hX1 = hB1;
        if (hasB2) U_ROUTE(eaB, ebB, hB0, hB1, t + 3 * ts);
        __builtin_amdgcn_sched_barrier(0);
        U_COMPUTE(wB, hX0, hX1, t + ts);
        if (!hasA2) break;
        t += 2 * ts;
    }
#undef U_ROUTE
#undef U_ISSUE
#undef U_COMPUTE
}
__device__ __forceinline__ void peer_v_sweep(int sl, int t0, int ts, const unsigned char* PV8, const unsigned* PK, const float* xin, const bf16_t* yin, float* xout, char* ldsw, int lane) {
    const int l8 = lane & 7, grp = lane >> 3;
    const unsigned char* tb = PV8 + (size_t)sl * (16384 * 128) + l8 * 16;
    const float* xb = xin + sl * 128 + l8 * 16 + 2 * grp; const bf16_t* yb = yin + sl * 128 + l8 * 16 + 2 * grp; float* xo = xout + sl * 128 + l8 * 16 + 2 * grp;
    char* lw = ldsw + lane * 64; const char* lr = ldsw + l8 * 64 + grp * 8;
#define V_ROUTE(PA, PB, XV, YV, TT) do { PA = PK[(size_t)(TT) * 128 + lane]; PB = PK[(size_t)(TT) * 128 + 64 + lane]; XV = *(const f32x2*)(xb + (size_t)(TT) * 2048); YV = *(const unsigned*)(yb + (size_t)(TT) * 2048); } while (0)
#define V_ISSUE(W, CW, PA, PB) do { _Pragma("unroll") for (int it = 0; it < 16; ++it) { const unsigned v_ = (unsigned)__shfl((int)(it < 8 ? PA : PB), (it & 7) * 8 + grp); \
        CW[it] = __uint_as_float(v_ & 0xffff0000u); W[it] = *(const u32x4*)(tb + (size_t)(v_ & 16383u) * 128); } } while (0)
#define V_COMPUTE(W, CW, XV, YV, TT) do { f32x2 out[8]; \
        _Pragma("unroll") for (int i = 0; i < 8; ++i) out[i] = (f32x2){0.f, 0.f}; \
        _Pragma("unroll") for (int it = 0; it < 16; ++it) { const f32x2 cw2 = {CW[it], CW[it]}; \
            _Pragma("unroll") for (int d = 0; d < 4; ++d) { out[2 * d] = __builtin_amdgcn_cvt_pk_f32_fp8((int)W[it][d], false) * cw2 + out[2 * d]; out[2 * d + 1] = __builtin_amdgcn_cvt_pk_f32_fp8((int)W[it][d], true) * cw2 + out[2 * d + 1]; } } \
        _Pragma("unroll") for (int i = 0; i < 4; ++i) *(f32x4*)(lw + i * 16) = (f32x4){out[2 * i][0], out[2 * i][1], out[2 * i + 1][0], out[2 * i + 1][1]}; \
        f32x2 acc_ = {XV[0] + bf_lo(YV), XV[1] + bf_hi(YV)}; \
        _Pragma("unroll") for (int g_ = 0; g_ < 8; ++g_) { const f32x2 p_ = *(const f32x2*)(lr + g_ * 512); acc_[0] += p_[0]; acc_[1] += p_[1]; } \
        *(f32x2*)(xo + (size_t)(TT) * 2048) = acc_; } while (0)
    int t = t0; if (t >= T) return;
    u32x4 wA[16], wB[16]; float cwA[16], cwB[16];
    unsigned paA, pbA, paB = 0u, pbB = 0u, paN = 0u, pbN = 0u, yA, yB = 0u, yN = 0u; f32x2 xA, xB = {0.f, 0.f}, xN = {0.f, 0.f};
    V_ROUTE(paA, pbA, xA, yA, t);
    V_ISSUE(wA, cwA, paA, pbA);
    if (t + ts < T) V_ROUTE(paB, pbB, xB, yB, t + ts);
    for (;;) {
        const bool hasB = t + ts < T, hasA2 = t + 2 * ts < T, hasB2 = t + 3 * ts < T;
        if (hasB) V_ISSUE(wB, cwB, paB, pbB);
        if (hasA2) V_ROUTE(paN, pbN, xN, yN, t + 2 * ts);
        __builtin_amdgcn_sched_barrier(0);
        V_COMPUTE(wA, cwA, xA, yA, t);
        if (!hasB) break;
        __builtin_amdgcn_sched_barrier(0);
        if (hasA2) V_ISSUE(wA, cwA, paN, pbN);
        xA = xN; yA = yN;
        const f32x2 xX = xB; const unsigned yX = yB;
        if (hasB2) V_ROUTE(paB, pbB, xB, yB, t + 3 * ts);
        __builtin_amdgcn_sched_barrier(0);
        V_COMPUTE(wB, cwB, xX, yX, t + ts);
        if (!hasA2) break;
        t += 2 * ts;
    }
#undef V_ROUTE
#undef V_ISSUE
#undef V_COMPUTE
}
__device__ __forceinline__ void final_norm_row(int t, float* xio, const float* gfin, int lane) {
    float* xr = xio + (size_t)t * 2048; f32x4 v[8]; float s = 0.f;
#pragma unroll
    for (int j = 0; j < 8; ++j) { v[j] = *(const f32x4*)(xr + 256 * j + 4 * lane); s += (v[j][0] * v[j][0] + v[j][1] * v[j][1]) + (v[j][2] * v[j][2] + v[j][3] * v[j][3]); }
    const float rstd = rsqrtf(wave_sum(s) * (1.f / DM) + EPS);
#pragma unroll
    for (int j = 0; j < 8; ++j) { const f32x4 gg = *(const f32x4*)(gfin + 256 * j + 4 * lane); *(f32x4*)(xr + 256 * j + 4 * lane) = v[j] * rstd * gg; }
}

struct Args {
    const float* x; const int* pos; const float* g_mix; const float* w_in; const float* sinks; const float* g_cq; const float* w_uq; const float* g_ckv; const float* w_ukv;
    const float* w_a; const float* w_b; const float* w_o; const float* g_ffn; const float* w_pq; const float* pkeys; const float* peer_u; const float* peer_v; const float* g_final;
    float* out; unsigned char* ws;
};
constexpr int LDS_BYTES = 147456;
#ifndef PH_MASK
#define PH_MASK 0x3ff
#endif
#define PH(k) if constexpr ((PH_MASK >> (k)) & 1)
#define DBL_PHASE 4
#ifndef DBL_PHASE
#define DBL_PHASE -1
#endif
#define REP(k) _Pragma("unroll 1") for (int rep_ = 0; rep_ < (int)(bst[1] > 100u ? 2 : 1); ++rep_)
#define PHASE_LOCALS size_t wofs_ = 0; asm volatile("" : "+s"(wofs_)); unsigned char* wsb = a.ws + wofs_; const int tid = opaque_tid(), lane = tid & 63, wid = __builtin_amdgcn_readfirstlane(tid >> 6); const int gw = vcu * NWAVES + wid; (void)lane; (void)gw; (void)wsb;

#define WSP(type, off) ((type*)(wsb + (off)))
__global__ void __launch_bounds__(NTHREADS, 2) fwd_mega(Args a) {
    extern __shared__ __attribute__((aligned(16))) unsigned char lds[];
    const int G = gridDim.x, bx = blockIdx.x, vcu = (G % 8 == 0) ? (bx % 8) * (G / 8) + bx / 8 : bx;
    const int NGW = G * NWAVES;
    PG8_LAS unsigned char* ldsg = (PG8_LAS unsigned char*)lds;
    volatile LAS unsigned* bst = (volatile LAS unsigned*)(ldsg + LDS_BYTES - 16);
    if (threadIdx.x == 0) { bst[0] = 0u; bst[1] = 0u; bst[2] = 0u; bst[3] = 0u; }
    __syncthreads();
    const XcdBarrier xbar = xcd_barrier_post((unsigned*)(a.ws + WS_CTL), bst);
#define GRID_SYNC() xcd_barrier(xbar)

    REP(0) {
    PH(0) { PHASE_LOCALS
        LAS float* scr = (LAS float*)(ldsg + wid * 16384);
        constexpr int I_IN = 32 * (IN_WB / 32), I_G = 32 * (IN_WG / 32), I_UQ = 8 * 48, I_UKV = 4 * 64, I_A = 16 * 64, I_O = 32 * 64;
        constexpr int NITEMS = I_IN + I_G + I_UQ + I_UKV + 2 * I_A + I_O;
        for (int it = gw; it < NITEMS; it += NGW) {
            int r = it;
            if (r < I_IN) { const int nb = r % (IN_WB / 32), kb = r / (IN_WB / 32); transpose_item(a.w_in, 2048, IN_W, WSP(bf16_t, WS_WIN), nb * 32, win_src(nb * 32), kb * 64, nullptr, scr, lane); continue; } r -= I_IN;
            if (r < I_G) { const int nb = r % (IN_WG / 32), kb = r / (IN_WG / 32); transpose_item_f8(a.w_in, 2048, IN_W, WSP(unsigned char, WS_WG8), nb * 32, 2368 + nb * 32, kb * 64, WG8_SCALE, scr, lane); continue; } r -= I_G;
            if (r < I_UQ) { const int nb = r % 48, kb = r / 48; transpose_item(a.w_uq, 512, 1536, WSP(bf16_t, WS_WUQ), nb * 32, wuq_src(nb * 32), kb * 64, a.g_cq, scr, lane); continue; } r -= I_UQ;
            if (r < I_UKV) { const int nb = r % 64, kb = r / 64; transpose_item(a.w_ukv, 256, 2048, WSP(bf16_t, WS_WUKV), nb * 32, nb * 32, kb * 64, a.g_ckv, scr, lane); continue; } r -= I_UKV;
            if (r < I_A) { const int nb = r % 64, kb = r / 64; transpose_item(a.w_a, 1024, 2048, WSP(bf16_t, WS_WA), nb * 32, nb * 32, kb * 64, nullptr, scr, lane); continue; } r -= I_A;
            if (r < I_A) { const int nb = r % 64, kb = r / 64; transpose_item(a.w_b, 1024, 2048, WSP(bf16_t, WS_WB), nb * 32, nb * 32, kb * 64, nullptr, scr, lane); continue; } r -= I_A;
            { const int nb = r % 64, kb = r / 64; transpose_item(a.w_o, 2048, 2048, WSP(bf16_t, WS_WO), nb * 32, nb * 32, kb * 64, nullptr, scr, lane); }
        }
        for (int r = gw; r < 32768; r += 4 * NGW) {
            f32x4 v0[8], v1[8], v2[8], v3[8];
            const int r1 = r + NGW, r2 = r + 2 * NGW, r3 = r + 3 * NGW;
            fp8_row_load(((r >> 14) ? a.peer_v : a.peer_u) + (size_t)(r & 16383) * 2048, v0, lane);
            fp8_row_load(((r1 >> 14) ? a.peer_v : a.peer_u) + (size_t)(r1 & 16383) * 2048, v1, lane);
            fp8_row_load(((r2 >> 14) ? a.peer_v : a.peer_u) + (size_t)(r2 & 16383) * 2048, v2, lane);
            fp8_row_load(((r3 >> 14) ? a.peer_v : a.peer_u) + (size_t)(r3 & 16383) * 2048, v3, lane);
#define ROW_STORE(V, R) do { if ((R) >> 14) fp8_row_store(V, WSP(unsigned char, WS_PV), (R) & 16383, WSP(float, WS_SCV) + ((R) & 16383), lane); \
                                else i8_row_store(V, WSP(unsigned char, WS_PU), (R) & 16383, WSP(float, WS_SCU) + ((R) & 16383), lane); } while (0)
            ROW_STORE(v0, r); ROW_STORE(v1, r1); ROW_STORE(v2, r2); ROW_STORE(v3, r3); }
#undef ROW_STORE
        { float* cosT = WSP(float, WS_COS); float* sinT = WSP(float, WS_SIN);
          for (int idx = bx * NTHREADS + tid; idx < T * 32; idx += G * NTHREADS) { const int tt = idx >> 5, i = idx & 31;
            const float inv = (float)(1.0 / pow(10000.0, (double)(2 * i) / 64.0)); const float ang = (float)a.pos[tt] * inv;
            cosT[idx] = (float)cos((double)ang); sinT[idx] = (float)sin((double)ang); } }
        for (int m = gw; m < T; m += 4 * NGW) rms_rows_bf16<4>(a.x, nullptr, a.g_mix, WSP(bf16_t, WS_H), m, NGW, lane, nullptr, nullptr, WSP(unsigned char, WS_H8));
        for (int u = bx; u < 256; u += G) fold_unit(u, a.w_pq, a.pkeys, WSP(bf16_t, WS_WPK), lane, wid);
    }
    GRID_SYNC();
    }
    REP(1) {
    PH(1) { PHASE_LOCALS
        { pg8::Gemm g{WSP(bf16_t, WS_H), WSP(bf16_t, WS_WIN), T, IN_WB, 2048, nullptr, nullptr}; pg8::StaticOrder S; S.init(T, IN_WB, G, bx);
          EpiIn E{WSP(bf16_t, WS_QA), WSP(bf16_t, WS_KA), WSP(bf16_t, WS_VA), WSP(bf16_t, WS_CQ), WSP(bf16_t, WS_CKV), WSP(bf16_t, WS_KR), (bf16_t*)a.out, (bf16_t*)a.out + (size_t)T * 2048,
                  WSP(float, WS_SSQ), WSP(float, WS_COS), WSP(float, WS_SIN)};
          pg8::gemm_phase<EpiIn, pg8::StaticOrder, true, true>(ldsg, g, S, E); }
        { pg8::Gemm g{WSP(bf16_t, WS_H8), WSP(bf16_t, WS_WG8), T, IN_WG, 1024, nullptr, nullptr}; pg8::GateOrder S; S.init(T, IN_WG, G, bx);
          EpiGate E{(bf16_t*)a.out, (bf16_t*)a.out + (size_t)T * 2048};
          pg8::gemm_phase<EpiGate, pg8::GateOrder, true, true, true>(ldsg, g, S, E); }
    }
    GRID_SYNC();
    }
    REP(2) {
    PH(2) { PHASE_LOCALS
        { pg8::Gemm g{WSP(bf16_t, WS_CQ), WSP(bf16_t, WS_WUQ), T, 1536, 512, nullptr, nullptr}; pg8::StaticOrder S; S.init(T, 1536, G, bx); EpiQ E{WSP(bf16_t, WS_QN), WSP(bf16_t, WS_QR), WSP(float, WS_SSQ), WSP(float, WS_COS), WSP(float, WS_SIN)};
          pg8::gemm_phase<EpiQ, pg8::StaticOrder, true, true>(ldsg, g, S, E); }
        { pg8::Gemm g{WSP(bf16_t, WS_CKV), WSP(bf16_t, WS_WUKV), T, 2048, 256, nullptr, nullptr}; pg8::StaticOrder S; S.init(T, 2048, G, bx); EpiKV E{WSP(bf16_t, WS_KN), WSP(bf16_t, WS_V), WSP(float, WS_SSQ)};
          pg8::gemm_phase<EpiKV, pg8::StaticOrder, true, true>(ldsg, g, S, E); }
        for (int u = vcu; u < 512; u += G) swa::unit(u, WSP(bf16_t, WS_QA), WSP(bf16_t, WS_KA), WSP(bf16_t, WS_VA), WSP(bf16_t, WS_AA), a.pos, a.sinks, (char*)lds);
    }
    GRID_SYNC();
    }
    REP(3) {
    PH(3) { PHASE_LOCALS mla::phase((char*)lds, vcu, G, WSP(bf16_t, WS_QN), WSP(bf16_t, WS_QR), WSP(bf16_t, WS_KN), WSP(bf16_t, WS_KR), WSP(bf16_t, WS_V), WSP(bf16_t, WS_AB)); }
    GRID_SYNC();
    }
    REP(4) {
    PH(4) { PHASE_LOCALS
        pg8::Gemm g{WSP(bf16_t, WS_AA), WSP(bf16_t, WS_WA), T, 2048, 1024, WSP(bf16_t, WS_AB), WSP(bf16_t, WS_WB)}; pg8::TwoSegOrder S; S.init(T, 2048, G, bx);
        EpiMix2 E{WSP(bf16_t, WS_MX), (const bf16_t*)a.out, (const bf16_t*)a.out + (size_t)T * 2048};
        pg8::gemm_phase<EpiMix2, pg8::TwoSegOrder, true, true>(ldsg, g, S, E);
    }
    GRID_SYNC();
    }
    REP(5) {
    PH(5) { PHASE_LOCALS
        pg8::Gemm g{WSP(bf16_t, WS_MX), WSP(bf16_t, WS_WO), T, 2048, 2048, nullptr, nullptr}; pg8::StaticOrder S; S.init(T, 2048, G, bx); EpiY E{WSP(bf16_t, WS_Y)};
        pg8::gemm_phase<EpiY, pg8::StaticOrder, true, true>(ldsg, g, S, E);
    }
    GRID_SYNC();
    }
    REP(6) {
    PH(6) { PHASE_LOCALS for (int m = gw; m < T; m += 2 * NGW) rms_rows_bf16<2>(a.x, WSP(bf16_t, WS_Y), a.g_ffn, WSP(bf16_t, WS_H), m, NGW, lane, WSP(unsigned char, WS_XQ), WSP(float, WS_SX)); }
    GRID_SYNC();
    }
    REP(7) {
    PH(7) { PHASE_LOCALS
        pg8::Gemm g{WSP(bf16_t, WS_H), WSP(bf16_t, WS_WPK), T, 2048, 2048, nullptr, nullptr}; pg8::StaticOrder S; S.init(T, 2048, G, bx); EpiF32 E{WSP(float, WS_SC)};
        pg8::gemm_phase<EpiF32, pg8::StaticOrder, true, true>(ldsg, g, S, E);
    }
    GRID_SYNC();
    }
    REP(8) {
    PH(8) { PHASE_LOCALS for (int item = bx * NTHREADS + tid; item < T * 8; item += G * NTHREADS) topk_item(item, WSP(float, WS_SC), WSP(int, WS_RI), WSP(float, WS_RG)); }
    GRID_SYNC();
    }
#ifdef DUMP_OFF
    GRID_SYNC();
    { PHASE_LOCALS
      for (size_t i = (size_t)bx * NTHREADS + tid; i < (size_t)T * DM; i += (size_t)G * NTHREADS) {
#ifdef DUMP_F32
          a.out[i] = ((const float*)(wsb + DUMP_OFF))[i];
#else
          a.out[i] = bf_lo((unsigned)((const bf16_t*)(wsb + DUMP_OFF))[i]);
#endif
      } }
#endif
    REP(9) PH(9) { PHASE_LOCALS
        const int nloc = (int)bst[0], nx = (int)bst[1], rank = (int)bst[2], xi = (int)bst[3];
        for (int sl = xi; sl < 16; sl += nx)
            peer_u_sweep(sl, rank * NWAVES + wid, nloc * NWAVES, WSP(unsigned char, WS_XQ), WSP(unsigned char, WS_PU), WSP(int, WS_RI), WSP(float, WS_AP), lane);
    }
    GRID_SYNC();
    REP(9) PH(9) { PHASE_LOCALS
        const float* AP = WSP(float, WS_AP); const int* RI = WSP(int, WS_RI); const float* RG = WSP(float, WS_RG); unsigned* CF = WSP(unsigned, WS_CF);
        const float* SCU = WSP(float, WS_SCU); const float* SCV = WSP(float, WS_SCV);
        for (int idx0 = bx * NTHREADS + tid; idx0 < T * 128; idx0 += 4 * G * NTHREADS) {
            int e[4]; float sacc[4], su[4], sv[4], rg[4];
#pragma unroll
            for (int u = 0; u < 4; ++u) { const int idx = idx0 + u * G * NTHREADS; e[u] = RI[idx] & 16383; rg[u] = RG[idx]; sacc[u] = 0.f; }
#pragma unroll
            for (int u = 0; u < 4; ++u) { const int idx = idx0 + u * G * NTHREADS;
#pragma unroll
                for (int q = 0; q < 16; ++q) sacc[u] += AP[(size_t)q * T * 128 + idx]; }
#pragma unroll
            for (int u = 0; u < 4; ++u) { su[u] = SCU[e[u]]; sv[u] = SCV[e[u]]; }
#pragma unroll
            for (int u = 0; u < 4; ++u) { const float cw = gelu_erf(sacc[u] * su[u] * WSP(float, WS_SX)[(idx0 + u * G * NTHREADS) >> 7]) * rg[u] * sv[u];
                CF[idx0 + u * G * NTHREADS] = (cvt_pk_bf16(0.f, cw) & 0xffff0000u) | (unsigned)e[u]; } }
    }
    GRID_SYNC();
    REP(9) PH(9) { PHASE_LOCALS
        const int nloc = (int)bst[0], nx = (int)bst[1], rank = (int)bst[2], xi = (int)bst[3];
        for (int sl = xi; sl < 16; sl += nx)
            peer_v_sweep(sl, rank * NWAVES + wid, nloc * NWAVES, WSP(unsigned char, WS_PV), WSP(unsigned, WS_CF), a.x, WSP(bf16_t, WS_Y), a.out, (char*)lds + wid * 4096, lane);
    }
    GRID_SYNC();
    REP(9) PH(9) { PHASE_LOCALS for (int t = gw; t < T; t += NGW) final_norm_row(t, a.out, a.g_final, lane); }
}

extern "C" void kernel_launch(void* const* d_in, const int* in_sizes, int n_in, void* d_out, int out_size, void* d_ws, size_t ws_size, hipStream_t stream) {
    static int grid = 0;
    if (grid == 0) {
        if (n_in != 18 || out_size != T * DM || ws_size < WS_END) { fprintf(stderr, "kernel_launch: unexpected shapes n_in %d out %d ws %zu\n", n_in, out_size, ws_size); grid = -1; return; }
        int dev = 0, cus = 0, per_cu = 0;
        (void)hipGetDevice(&dev);
        (void)hipDeviceGetAttribute(&cus, hipDeviceAttributeMultiprocessorCount, dev);
        (void)hipFuncSetAttribute((const void*)fwd_mega, hipFuncAttributeMaxDynamicSharedMemorySize, LDS_BYTES);
        (void)hipOccupancyMaxActiveBlocksPerMultiprocessor(&per_cu, (const void*)fwd_mega, NTHREADS, LDS_BYTES);
        if (per_cu < 1) { fprintf(stderr, "kernel_launch: occupancy query reports %d blocks per CU\n", per_cu); }
        (void)hipGetLastError();
        if (cus < 256) fprintf(stderr, "kernel_launch: built for a 256-CU device (one workgroup per CU); found %d CUs\n", cus);
        grid = 256;
    }
    if (grid < 0) return;
    (void)hipMemsetAsync((char*)d_ws + WS_CTL, 0, CTL_ZERO_BYTES, stream);
    Args a{};
    a.x = (const float*)d_in[0]; a.pos = (const int*)d_in[1]; a.g_mix = (const float*)d_in[2]; a.w_in = (const float*)d_in[3]; a.sinks = (const float*)d_in[4];
    a.g_cq = (const float*)d_in[5]; a.w_uq = (const float*)d_in[6]; a.g_ckv = (const float*)d_in[7]; a.w_ukv = (const float*)d_in[8];
    a.w_a = (const float*)d_in[9]; a.w_b = (const float*)d_in[10]; a.w_o = (const float*)d_in[11]; a.g_ffn = (const float*)d_in[12]; a.w_pq = (const float*)d_in[13];
    a.pkeys = (const float*)d_in[14]; a.peer_u = (const float*)d_in[15]; a.peer_v = (const float*)d_in[16]; a.g_final = (const float*)d_in[17];
    a.out = (float*)d_out; a.ws = (unsigned char*)d_ws;
    void* args[] = {&a};
    hipError_t e = hipLaunchCooperativeKernel((const void*)fwd_mega, dim3(grid), dim3(NTHREADS), args, LDS_BYTES, stream);
    if (e != hipSuccess) fprintf(stderr, "cooperative launch failed: %s (grid %d)\n", hipGetErrorString(e), grid);
}
```

```cpp
#include <hip/hip_runtime.h>
#include <hip/hip_bf16.h>
#include <hip/hip_cooperative_groups.h>
#include <cstdio>
#include <cstdint>
#include <cmath>
namespace cg = cooperative_groups;

constexpr int BATCH = 2, SEQ = 8192, DM = 2048, T = BATCH * SEQ;
constexpr int NWAVES = 8, NTHREADS = 512;
constexpr int IN_W = 6464, IN_WP = 6656, IN_WB = 2560, IN_WG = 4096;
constexpr float H8_SCALE = 16.f, WG8_SCALE = 2048.f, MX8_SCALE = 64.f, WO8_SCALE = 2048.f;
constexpr float EPS = 1e-6f;

typedef unsigned short bf16_t;
typedef short bf16x8 __attribute__((ext_vector_type(8)));
typedef float f32x4 __attribute__((ext_vector_type(4)));
typedef float f32x16 __attribute__((ext_vector_type(16)));
typedef unsigned u32x4 __attribute__((ext_vector_type(4)));
typedef unsigned u32x2 __attribute__((ext_vector_type(2)));
typedef short s16x4 __attribute__((ext_vector_type(4)));
#define LAS __attribute__((address_space(3)))

typedef float f32x2_t __attribute__((ext_vector_type(2))); typedef __bf16 bf16x2v_t __attribute__((ext_vector_type(2)));
__device__ __forceinline__ unsigned cvt_pk_bf16(float lo, float hi) { f32x2_t v = {lo, hi}; bf16x2v_t b = __builtin_convertvector(v, bf16x2v_t); return __builtin_bit_cast(unsigned, b); }
__device__ __forceinline__ float bf_lo(unsigned w) { return __uint_as_float(w << 16); }
__device__ __forceinline__ float bf_hi(unsigned w) { return __uint_as_float(w & 0xffff0000u); }
__device__ __forceinline__ u32x4 pack8u(f32x4 a, f32x4 b) { u32x4 w = {cvt_pk_bf16(a[0], a[1]), cvt_pk_bf16(a[2], a[3]), cvt_pk_bf16(b[0], b[1]), cvt_pk_bf16(b[2], b[3])}; return w; }
__device__ __forceinline__ bf16x8 pack8(f32x4 a, f32x4 b) { u32x4 w = pack8u(a, b); return __builtin_bit_cast(bf16x8, w); }
__device__ __forceinline__ int opaque_tid() { int t = threadIdx.x; asm volatile("" : "+v"(t)); return t; }
__device__ __forceinline__ const char* uni_ptr(const void* p) {
    const unsigned long long v = (unsigned long long)p; const unsigned lo = __builtin_amdgcn_readfirstlane((unsigned)v), hi = __builtin_amdgcn_readfirstlane((unsigned)(v >> 32));
    return (const char*)(((unsigned long long)hi << 32) | lo);
}
__device__ __forceinline__ unsigned pack_i8x4(f32x4 y) {
    const int a = (int)rintf(y[0]), b = (int)rintf(y[1]), c = (int)rintf(y[2]), d = (int)rintf(y[3]);
    return (unsigned)(a & 0xff) | ((unsigned)(b & 0xff) << 8) | ((unsigned)(c & 0xff) << 16) | ((unsigned)d << 24);
}
__device__ __forceinline__ float wave_sum(float v) {
#pragma unroll
    for (int o = 1; o < 64; o <<= 1) v += __shfl_xor(v, o);
    return v;
}

constexpr size_t MiB = 1u << 20;
constexpr size_t WS_COS = 1 * MiB, WS_SIN = 3 * MiB, WS_SSQ = 5 * MiB, WS_KR = 6 * MiB;
constexpr size_t WS_WIN = 8 * MiB, WS_WUQ = 34 * MiB, WS_WUKV = 36 * MiB, WS_WA = 37 * MiB, WS_WB = 41 * MiB, WS_WO = 45 * MiB, WS_WPK = 53 * MiB;
constexpr size_t WS_CTL = 0, CTL_ZERO_BYTES = 16384;
constexpr size_t WS_PU = 61 * MiB, WS_PV = 93 * MiB, WS_SCU = 125 * MiB, WS_SCV = 125 * MiB + 65536;
constexpr size_t WS_H = 189 * MiB;
constexpr size_t WS_QA = 253 * MiB, WS_KA = 285 * MiB, WS_VA = 293 * MiB, WS_CQ = 301 * MiB, WS_CKV = 317 * MiB;
constexpr size_t WS_RI = 461 * MiB, WS_RG = 469 * MiB;
constexpr size_t WS_XQ = 8 * MiB, WS_SX = 125 * MiB + 131072;
constexpr size_t WS_WO8 = 45 * MiB;
constexpr size_t WS_H8 = 325 * MiB, WS_WG8 = 357 * MiB;
constexpr size_t WS_Y = 253 * MiB;
constexpr size_t WS_QN = 325 * MiB, WS_QR = 357 * MiB, WS_KN = 373 * MiB, WS_V = 405 * MiB;
constexpr size_t WS_AA = 437 * MiB, WS_AB = 469 * MiB, WS_END = 501 * MiB;
constexpr size_t WS_MX = 325 * MiB;
constexpr size_t WS_SC = 325 * MiB;
constexpr size_t WS_AP = 325 * MiB, WS_CF = 453 * MiB, WS_SSQ2 = 5 * MiB;


#define XB_TMO      128
#define XB_XCNT(j)  (256  + 64 * (j))
#define XB_XSUB(j)  (1280 + 64 * (j))
#define XB_XGEN(j)  (2304 + 64 * (j))
#define XB_TOP      3328
#define XB_TOPGEN   3392
#define XCD_BAR_WORDS 3456
#define XB_SPIN_CAP (1u << 22)
__device__ __forceinline__ unsigned xb_ld(unsigned* p)              { return __hip_atomic_load(p, __ATOMIC_RELAXED, __HIP_MEMORY_SCOPE_AGENT); }
__device__ __forceinline__ unsigned xb_add(unsigned* p, unsigned v) { return __hip_atomic_fetch_add(p, v, __ATOMIC_RELAXED, __HIP_MEMORY_SCOPE_AGENT); }
__device__ __forceinline__ unsigned xb_xcc_id() { return (unsigned)__builtin_amdgcn_s_getreg((3 << 11) | 20) & 0xFu; }
#define XB_SPIN(cond, bar) do { unsigned _sp = 0; while (cond) { __builtin_amdgcn_s_sleep(1); \
    if ((++_sp & 255u) == 0u) { if (xb_ld(&(bar)[XB_TMO])) break; if (_sp > XB_SPIN_CAP) { atomicAdd(&(bar)[XB_TMO], 1u); break; } } } } while (0)
struct XcdBarrier { unsigned* bar; unsigned x; volatile LAS unsigned* st; };
__device__ __forceinline__ XcdBarrier xcd_barrier_post(unsigned* bar, volatile LAS unsigned* st) {
    XcdBarrier b; b.bar = bar; b.x = xb_xcc_id(); b.st = st;
    if (threadIdx.x == 0) st[2] = xb_add(&bar[XB_XCNT(b.x)], 1u);
    return b;
}
__device__ __forceinline__ void xcd_barrier_complete(unsigned* bar, unsigned x, unsigned& nloc, unsigned& nx, unsigned& xi) {
    const unsigned G = gridDim.x * gridDim.y * gridDim.z;
    unsigned sum, cnt, mine, below, sp = 0u;
    for (;;) {
        sum = 0u; cnt = 0u; mine = 0u; below = 0u;
#pragma unroll
        for (unsigned j = 0; j < 16; ++j) { const unsigned c = xb_ld(&bar[XB_XCNT(j)]); sum += c; cnt += (c > 0u) ? 1u : 0u; mine = (j == x) ? c : mine; below += (c > 0u && j < x) ? 1u : 0u; }
        if (sum == G) break;
        __builtin_amdgcn_s_sleep(1);
        if ((++sp & 255u) == 0u) { if (xb_ld(&bar[XB_TMO])) break; if (sp > XB_SPIN_CAP) { atomicAdd(&bar[XB_TMO], 1u); break; } }
    }
    nloc = mine > 0u ? mine : 1u; nx = cnt > 0u ? cnt : 1u; xi = below;
}
__device__ __forceinline__ void xcd_barrier(const XcdBarrier& b) {
    asm volatile("s_waitcnt vmcnt(0)" ::: "memory");
    __syncthreads();
    if (threadIdx.x == 0) {
        unsigned* bar = b.bar;
        __builtin_amdgcn_s_waitcnt(0);
        unsigned nloc = b.st[0], nx = b.st[1];
        if (nloc == 0u) { unsigned xi = 0u; xcd_barrier_complete(bar, b.x, nloc, nx, xi); b.st[0] = nloc; b.st[1] = nx; b.st[3] = xi; }
        const unsigned old = xb_add(&bar[XB_XSUB(b.x)], 1u);
        const unsigned gen = old / nloc;
        if (old + 1u == (gen + 1u) * nloc) {
            __builtin_amdgcn_fence(__ATOMIC_RELEASE, "agent");
            asm volatile("s_waitcnt vmcnt(0)" ::: "memory");
            const unsigned og = xb_add(&bar[XB_TOP], 1u);
            const unsigned tg = og / nx;
            if (og + 1u == (tg + 1u) * nx) xb_add(&bar[XB_TOPGEN], 1u);
            else XB_SPIN(xb_ld(&bar[XB_TOPGEN]) == tg, bar);
            __builtin_amdgcn_fence(__ATOMIC_ACQUIRE, "agent");
            xb_add(&bar[XB_XGEN(b.x)], 1u);
            asm volatile("s_waitcnt vmcnt(0)" ::: "memory");
        } else {
            XB_SPIN(xb_ld(&bar[XB_XGEN(b.x)]) == gen, bar);
            __builtin_amdgcn_fence(__ATOMIC_ACQUIRE, "agent");
            asm volatile("s_waitcnt vmcnt(0)" ::: "memory");
        }
    }
    __syncthreads();
}

namespace pg8 {
#define PG8_LAS __attribute__((address_space(3)))
constexpr int BM = 256, BK = 64, HALF = 128, HTB = HALF * BK * 2, STAGE_BYTES = 8 * HTB, NXCD = 8, WGM = 8;
__host__ __device__ __forceinline__ int lds_byte(int r, int c) { const int st = (r >> 4) * 2 + (c >> 5), rr = r & 15, cc = c & 31, ob = rr * 64 + cc * 2; return st * 1024 + (ob ^ (((ob >> 9) & 1) << 5)); }
__host__ __device__ __forceinline__ void stage_rc(int b, int& R, int& C) { const int st = b / 1024, sb = b % 1024, swz = sb ^ (((sb >> 9) & 1) << 5); R = (st >> 1) * 16 + swz / 64; C = (st & 1) * 32 + (swz % 64) / 2; }
__host__ __device__ __forceinline__ int perm32(int rho) { const int n = rho >> 4, i = rho & 15; return 8 * (i >> 2) + 4 * n + (i & 3); }
struct Unit { int pm, pn, seg; };
struct Gemm { const bf16_t* A; const bf16_t* Bt; int M, N, K; const bf16_t* A2; const bf16_t* Bt2; };
struct StaticOrder {
    int nM, nN, nwg, G, c;
    __host__ __device__ void init(int M, int N, int G_, int c_) { nM = M / BM; nN = N / BM; nwg = nM * nN; G = G_; c = c_; }
    __host__ __device__ bool next(int i, Unit& u) const {
        const long L = (long)i * G + c; if (L >= nwg) return false;
        int wgid = (int)L; { const int q = nwg / NXCD, r = nwg % NXCD, xcd = wgid % NXCD, off = wgid / NXCD; wgid = (xcd < r ? xcd * (q + 1) : r * (q + 1) + (xcd - r) * q) + off; }
        const int nig = WGM * nN, gid = wgid / nig, fm = gid * WGM, gsz = (nM - fm) < WGM ? (nM - fm) : WGM;
        u.pm = fm + ((wgid % nig) % gsz); u.pn = (wgid % nig) / gsz; u.seg = 0; return true;
    }
    __device__ __forceinline__ void a_ready(const Unit&) const {}
    __device__ __forceinline__ void done(const Unit&) const {}
};
struct GateOrder {
    StaticOrder base; int c, G;
    __host__ __device__ void init(int M, int N, int G_, int c_) { base.init(M, N, G_, 0); c = c_; G = G_; }
    __host__ __device__ bool next(int i, Unit& u) const {
        const int h = G / 2; int L;
        if (G != 256 || base.nwg != 1024) { L = i * G + c; }
        else if (c < h) { if (i >= 3) return false; L = c + h * i; }
        else { if (i >= 5) return false; L = 3 * h + (c - h) + h * i; }
        if (L >= base.nwg) return false;
        StaticOrder b2 = base; b2.G = 1; b2.c = L; return b2.next(0, u);
    }
    __device__ __forceinline__ void a_ready(const Unit&) const {}
    __device__ __forceinline__ void done(const Unit&) const {}
};
struct TwoSegOrder {
    StaticOrder base;
    __host__ __device__ void init(int M, int N, int G_, int c_) { base.init(M, N, G_, c_); }
    __host__ __device__ bool next(int i, Unit& u) const { if (!base.next(i >> 1, u)) return false; u.seg = i & 1; return true; }
    __device__ __forceinline__ void a_ready(const Unit&) const {}
    __device__ __forceinline__ void done(const Unit&) const {}
};

typedef int i32x8 __attribute__((ext_vector_type(8)));
typedef unsigned u32x8 __attribute__((ext_vector_type(8)));
template <class Epi, class Sched, bool ALIGN_EPI = false, bool SP2 = false, bool F8 = false>
__device__ __forceinline__ void gemm_phase(PG8_LAS unsigned char* lds, const Gemm g, const Sched& S, const Epi& E) {
    const int tid = opaque_tid(), wid = __builtin_amdgcn_readfirstlane(tid >> 6), lane = tid & 63, wr = wid >> 2, wc = wid & 3, fr = lane & 15, fq = lane >> 4;
    const int K = g.K, nt = K / BK;
    unsigned voffA[2], voffB[2];
#pragma unroll
    for (int i = 0; i < 2; ++i) { int R, C; stage_rc(tid * 16 + i * 8192, R, C); const int Rb = Epi::PERM ? ((R & ~31) + perm32(R & 31)) : R;
        voffA[i] = (unsigned)(R * K + C) * 2u; voffB[i] = (unsigned)(Rb * K + C) * 2u; }
    const size_t kstep = (size_t)(BK * 2);
    const size_t hstep = (size_t)HALF * K * 2;
    const size_t tstep = 2 * hstep;
    const unsigned ldsw = (unsigned)wid * 1024u;
    const int aoff = lds_byte(wr * 64 + fr, fq * 8), boff = lds_byte(wc * 32 + fr, fq * 8);
#define PG8_SA(b, h) (((b) * 2 + (h)) * HTB)
#define PG8_SB(b, h) ((4 + (b) * 2 + (h)) * HTB)
#define PG8_STAGE(bufoff, gbase, voff) do { _Pragma("unroll") for (int _i = 0; _i < 2; ++_i) \
        __builtin_amdgcn_global_load_lds((const unsigned*)((const char*)(gbase) + (voff)[_i]), (PG8_LAS unsigned*)(lds + (bufoff) + ldsw + _i * 8192), 16, 0, 0); } while (0)
#define PG8_CAT(x0, x1) __builtin_shufflevector((x0), (x1), 0, 1, 2, 3, 4, 5, 6, 7)
#define PG8_LO(x) __builtin_bit_cast(bf16x8, __builtin_shufflevector((x), (x), 0, 1, 2, 3))
#define PG8_HI(x) __builtin_bit_cast(bf16x8, __builtin_shufflevector((x), (x), 4, 5, 6, 7))
#define PG8_LDA(dst, b, h) do { _Pragma("unroll") for (int m = 0; m < 4; ++m) dst[m] = PG8_CAT(*(const PG8_LAS u32x4*)(lds + PG8_SA(b, h) + aoff + m * 2048), *(const PG8_LAS u32x4*)(lds + PG8_SA(b, h) + aoff + m * 2048 + 1024)); } while (0)
#define PG8_LDB(dst, b, h) do { _Pragma("unroll") for (int n = 0; n < 2; ++n) dst[n] = PG8_CAT(*(const PG8_LAS u32x4*)(lds + PG8_SB(b, h) + boff + n * 2048), *(const PG8_LAS u32x4*)(lds + PG8_SB(b, h) + boff + n * 2048 + 1024)); } while (0)
#define PG8_MMA(ai, bj, At, Bt) do { __builtin_amdgcn_s_setprio(1); _Pragma("unroll") for (int m = 0; m < 4; ++m) _Pragma("unroll") for (int n = 0; n < 2; ++n) { \
        if constexpr (F8) { asm volatile("v_mfma_scale_f32_16x16x128_f8f6f4 %0, %1, %2, %0, %3, %3 op_sel_hi:[0,0,0]" : "+v"(acc[ai][bj][m][n]) : "v"(Bt[n]), "v"(At[m]), "v"(mxscale)); }     \
        else { acc[ai][bj][m][n] = __builtin_amdgcn_mfma_f32_16x16x32_bf16(PG8_LO(Bt[n]), PG8_LO(At[m]), acc[ai][bj][m][n], 0, 0, 0); \
               acc[ai][bj][m][n] = __builtin_amdgcn_mfma_f32_16x16x32_bf16(PG8_HI(Bt[n]), PG8_HI(At[m]), acc[ai][bj][m][n], 0, 0, 0); } } \
        __builtin_amdgcn_s_setprio(0); } while (0)
#define PG8_WAIT_V(n) asm volatile("s_waitcnt vmcnt(" #n ")" ::: "memory")
#define PG8_WAIT_L(n) asm volatile("s_waitcnt lgkmcnt(" #n ")" ::: "memory")
#define PG8_BAR __builtin_amdgcn_s_barrier()
#define PG8_SCHED __builtin_amdgcn_sched_barrier(0)
    Unit cur, nxt; int ui = 0;
    if (!S.next(0, cur)) return;
    f32x4 acc[2][2][4][2];
#pragma unroll
    for (int a = 0; a < 2; ++a)
#pragma unroll
        for (int b = 0; b < 2; ++b)
#pragma unroll
            for (int m = 0; m < 4; ++m)
#pragma unroll
                for (int n = 0; n < 2; ++n) acc[a][b][m][n] = (f32x4){0.f, 0.f, 0.f, 0.f};
    const unsigned mxscale = 0x7f7f7f7fu;
    u32x8 At[4], B0[2], B1[2];
    const char* cA = (const char*)(cur.seg ? g.A2 : g.A) + (size_t)cur.pm * tstep; const char* cB = (const char*)(cur.seg ? g.Bt2 : g.Bt) + (size_t)cur.pn * tstep;
    S.a_ready(cur);
    if constexpr (SP2) {
        PG8_STAGE(PG8_SB(0, 0), cB, voffB); PG8_STAGE(PG8_SB(0, 1), cB + hstep, voffB); PG8_STAGE(PG8_SA(0, 0), cA, voffA); PG8_STAGE(PG8_SA(0, 1), cA + hstep, voffA);
        if (wr == 1) PG8_BAR;
        PG8_WAIT_V(2); PG8_BAR;
        PG8_STAGE(PG8_SB(1, 0), cB + kstep, voffB); PG8_STAGE(PG8_SA(1, 0), cA + kstep, voffA); PG8_STAGE(PG8_SB(1, 1), cB + hstep + kstep, voffB);
        PG8_WAIT_V(6); PG8_BAR;
    } else {
        PG8_STAGE(PG8_SB(0, 0), cB, voffB); PG8_STAGE(PG8_SA(0, 0), cA, voffA); PG8_STAGE(PG8_SB(0, 1), cB + hstep, voffB); PG8_STAGE(PG8_SA(0, 1), cA + hstep, voffA);
        if (wr == 1) PG8_BAR;
        PG8_WAIT_V(4); PG8_BAR;
        PG8_STAGE(PG8_SB(1, 0), cB + kstep, voffB); PG8_STAGE(PG8_SA(1, 0), cA + kstep, voffA); PG8_STAGE(PG8_SB(1, 1), cB + hstep + kstep, voffB);
        PG8_WAIT_V(6); PG8_BAR;
    }
    for (;;) {
        const bool has_next = S.next(ui + 1, nxt);
        const char* nA = has_next ? (const char*)(nxt.seg ? g.A2 : g.A) + (size_t)nxt.pm * tstep : cA; const char* nB = has_next ? (const char*)(nxt.seg ? g.Bt2 : g.Bt) + (size_t)nxt.pn * tstep : cB;
        for (int t = 0; t < nt; t += 2) {
            const bool last = (t == nt - 2);
            const char* a1 = cA + (size_t)(t + 1) * kstep;
            const char* a2 = last ? nA : cA + (size_t)(t + 2) * kstep; const char* b2 = last ? nB : cB + (size_t)(t + 2) * kstep;
            const char* a3 = a2 + kstep; const char* b3 = b2 + kstep;
            if (last && has_next) S.a_ready(nxt);
            if constexpr (SP2) {
            PG8_LDB(B0, 0, 0); PG8_LDB(B1, 0, 1); PG8_SCHED; PG8_LDA(At, 0, 0); PG8_STAGE(PG8_SA(1, 1), a1 + hstep, voffA);
            PG8_WAIT_V(8); PG8_WAIT_L(0); PG8_BAR; PG8_MMA(0, 0, At, B0); PG8_MMA(0, 1, At, B1); PG8_BAR; PG8_SCHED;
            PG8_LDA(At, 0, 1); PG8_STAGE(PG8_SB(0, 0), b2, voffB); PG8_STAGE(PG8_SB(0, 1), b2 + hstep, voffB); PG8_STAGE(PG8_SA(0, 0), a2, voffA);
            PG8_WAIT_V(8); PG8_WAIT_L(0); PG8_BAR; PG8_MMA(1, 0, At, B0); PG8_MMA(1, 1, At, B1); PG8_BAR; PG8_SCHED;
            PG8_LDB(B0, 1, 0); PG8_LDB(B1, 1, 1); PG8_SCHED; PG8_LDA(At, 1, 0); PG8_STAGE(PG8_SA(0, 1), a2 + hstep, voffA);
            PG8_WAIT_V(8); PG8_WAIT_L(0); PG8_BAR; PG8_MMA(0, 0, At, B0); PG8_MMA(0, 1, At, B1); PG8_BAR; PG8_SCHED;
            PG8_LDA(At, 1, 1); PG8_STAGE(PG8_SB(1, 0), b3, voffB); PG8_STAGE(PG8_SB(1, 1), b3 + hstep, voffB); PG8_STAGE(PG8_SA(1, 0), a3, voffA);
            PG8_WAIT_V(8); PG8_WAIT_L(0); PG8_BAR; PG8_MMA(1, 0, At, B0); PG8_MMA(1, 1, At, B1); PG8_BAR; PG8_SCHED;
            } else {
            PG8_LDB(B0, 0, 0); PG8_SCHED; PG8_LDA(At, 0, 0); PG8_STAGE(PG8_SA(1, 1), a1 + hstep, voffA);
            PG8_WAIT_L(8); PG8_BAR; PG8_WAIT_L(0); PG8_MMA(0, 0, At, B0); PG8_BAR; PG8_SCHED;
            PG8_LDB(B1, 0, 1); PG8_STAGE(PG8_SB(0, 0), b2, voffB);
            PG8_BAR; PG8_WAIT_L(0); PG8_MMA(0, 1, At, B1); PG8_BAR;
            PG8_LDA(At, 0, 1); PG8_STAGE(PG8_SA(0, 0), a2, voffA);
            PG8_BAR; PG8_WAIT_L(0); PG8_MMA(1, 0, At, B0); PG8_BAR; PG8_SCHED;
            PG8_STAGE(PG8_SB(0, 1), b2 + hstep, voffB);
            PG8_WAIT_V(6); PG8_BAR; PG8_MMA(1, 1, At, B1); PG8_BAR;
            PG8_LDB(B0, 1, 0); PG8_SCHED; PG8_LDA(At, 1, 0); PG8_STAGE(PG8_SA(0, 1), a2 + hstep, voffA);
            PG8_WAIT_L(8); PG8_BAR; PG8_WAIT_L(0); PG8_MMA(0, 0, At, B0); PG8_BAR; PG8_SCHED;
            PG8_LDB(B1, 1, 1); PG8_STAGE(PG8_SB(1, 0), b3, voffB);
            PG8_BAR; PG8_WAIT_L(0); PG8_MMA(0, 1, At, B1); PG8_BAR;
            PG8_LDA(At, 1, 1); PG8_STAGE(PG8_SA(1, 0), a3, voffA);
            PG8_BAR; PG8_WAIT_L(0); PG8_MMA(1, 0, At, B0); PG8_BAR; PG8_SCHED;
            PG8_STAGE(PG8_SB(1, 1), b3 + hstep, voffB);
            PG8_WAIT_V(6); PG8_BAR; PG8_MMA(1, 1, At, B1); PG8_BAR;
            }
        }
        if constexpr (ALIGN_EPI) { if (wr == 0) PG8_BAR; }
        if constexpr (F8) asm volatile("s_nop 15\n\ts_nop 15" ::: "memory");
        if constexpr (Epi::TWO_SEG) { if (cur.seg == 0) E.mid(acc, cur, wr, wc, fr, fq); else E(acc, cur, wr, wc, fr, fq); } else { E(acc, cur, wr, wc, fr, fq); }
        S.done(cur);
        if (!has_next) break;
        if (!Epi::TWO_SEG || nxt.seg == 0)
#pragma unroll
        for (int a = 0; a < 2; ++a)
#pragma unroll
            for (int b = 0; b < 2; ++b)
#pragma unroll
                for (int m = 0; m < 4; ++m)
#pragma unroll
                    for (int n = 0; n < 2; ++n) acc[a][b][m][n] = (f32x4){0.f, 0.f, 0.f, 0.f};
        cur = nxt; cA = nA; cB = nB; ++ui;
        if constexpr (ALIGN_EPI) { if (wr == 1) PG8_BAR; }
    }
    PG8_WAIT_V(0);
    if constexpr (!ALIGN_EPI) { if (wr == 0) PG8_BAR; }
    PG8_BAR;
#undef PG8_SA
#undef PG8_SB
#undef PG8_STAGE
#undef PG8_LDA
#undef PG8_LDB
#undef PG8_MMA
#undef PG8_CAT
#undef PG8_LO
#undef PG8_HI
#undef PG8_WAIT_V
#undef PG8_WAIT_L
#undef PG8_BAR
#undef PG8_SCHED
}
}

typedef f32x4 Acc[2][2][4][2];
#define EPI_LOOP_AM _Pragma("unroll") for (int ai = 0; ai < 2; ++ai) _Pragma("unroll") for (int m = 0; m < 4; ++m)

struct EpiIn {
    static constexpr bool PERM = true, AFTER_DRAIN = false, TWO_SEG = false;
    bf16_t *QA, *KA, *VA, *CQ, *CKV, *KR, *SA, *SB; float* SSQ; const float *cosT, *sinT;
    __device__ __forceinline__ void operator()(const Acc& acc, const pg8::Unit& u, int, int, int, int) const {
        const int tid_ = opaque_tid(), wid_ = tid_ >> 6, wr = wid_ >> 2, wc = wid_ & 3, fr = tid_ & 15, fq = (tid_ >> 4) & 3;
        const int pn = u.pn, row0 = u.pm * 256 + wr * 64 + fr, cw = wc * 32 + 8 * fq;
        if (pn == 9) {
            if (wc == 0) {
                EPI_LOOP_AM { const int row = row0 + ai * 128 + m * 16;
                    const f32x4 c0 = *(const f32x4*)(cosT + (size_t)row * 32 + 8 * fq), c1 = *(const f32x4*)(cosT + (size_t)row * 32 + 8 * fq + 4);
                    const f32x4 s0 = *(const f32x4*)(sinT + (size_t)row * 32 + 8 * fq), s1 = *(const f32x4*)(sinT + (size_t)row * 32 + 8 * fq + 4);
                    const f32x4 a0 = acc[ai][0][m][0], a1 = acc[ai][0][m][1], b0 = acc[ai][1][m][0], b1 = acc[ai][1][m][1];
                    *(u32x4*)(KR + (size_t)row * 64 + 8 * fq) = pack8u(a0 * c0 - b0 * s0, a1 * c1 - b1 * s1);
                    *(u32x4*)(KR + (size_t)row * 64 + 32 + 8 * fq) = pack8u(a0 * s0 + b0 * c0, a1 * s1 + b1 * c1); }
            }
            return;
        }
        if (pn >= 10) {
            bf16_t* base = pn < 18 ? SA : SB; const int col0 = (pn < 18 ? pn - 10 : pn - 18) * 256 + cw;
            EPI_LOOP_AM { const int row = row0 + ai * 128 + m * 16;
#pragma unroll
                for (int bj = 0; bj < 2; ++bj) { f32x4 v0 = acc[ai][bj][m][0], v1 = acc[ai][bj][m][1];
#pragma unroll
                    for (int e = 0; e < 4; ++e) { v0[e] = 1.f / (1.f + __expf(-v0[e])); v1[e] = 1.f / (1.f + __expf(-v1[e])); }
                    *(u32x4*)(base + (size_t)row * 2048 + col0 + bj * 128) = pack8u(v0, v1); } }
            return;
        }
        bf16_t* base; int ld, col0, slot = -1;
        if (pn < 4) { base = QA; ld = 1024; col0 = pn * 256; }
        else if (pn == 4) { base = KA; ld = 256; col0 = 0; }
        else if (pn == 5) { base = VA; ld = 256; col0 = 0; }
        else if (pn < 8) { base = CQ; ld = 512; col0 = (pn - 6) * 256; slot = (pn - 6) * 4; }
        else { base = CKV; ld = 256; col0 = 0; slot = 8; }
        EPI_LOOP_AM { const int row = row0 + ai * 128 + m * 16; float ss = 0.f;
#pragma unroll
            for (int bj = 0; bj < 2; ++bj) { const f32x4 v0 = acc[ai][bj][m][0], v1 = acc[ai][bj][m][1];
                ss += (v0[0] * v0[0] + v0[1] * v0[1]) + (v0[2] * v0[2] + v0[3] * v0[3]) + (v1[0] * v1[0] + v1[1] * v1[1]) + (v1[2] * v1[2] + v1[3] * v1[3]);
                *(u32x4*)(base + (size_t)row * ld + col0 + bj * 128 + cw) = pack8u(v0, v1); }
            if (slot >= 0) { ss += __shfl_xor(ss, 16); ss += __shfl_xor(ss, 32); if (fq == 0) SSQ[(size_t)row * 12 + slot + wc] = ss; } }
    }
};

struct EpiGate {
    static constexpr bool PERM = true, AFTER_DRAIN = false, TWO_SEG = false;
    bf16_t *SA, *SB;
    __device__ __forceinline__ void operator()(const Acc& acc, const pg8::Unit& u, int, int, int, int) const {
        const int tid_ = opaque_tid(), wid_ = tid_ >> 6, wr = wid_ >> 2, wc = wid_ & 3, fr = tid_ & 15, fq = (tid_ >> 4) & 3;
        const int pn = u.pn, row0 = u.pm * 256 + wr * 64 + fr, cw = wc * 32 + 8 * fq;
        bf16_t* base = pn < 8 ? SA : SB; const int col0 = (pn & 7) * 256 + cw;
        constexpr float ds = -1.f / (H8_SCALE * WG8_SCALE);
        EPI_LOOP_AM { const int row = row0 + ai * 128 + m * 16;
#pragma unroll
            for (int bj = 0; bj < 2; ++bj) { f32x4 v0 = acc[ai][bj][m][0], v1 = acc[ai][bj][m][1];
#pragma unroll
                for (int e = 0; e < 4; ++e) { v0[e] = 1.f / (1.f + __expf(v0[e] * ds)); v1[e] = 1.f / (1.f + __expf(v1[e] * ds)); }
                *(u32x4*)(base + (size_t)row * 2048 + col0 + bj * 128) = pack8u(v0, v1); } }
    }
};
struct EpiQ {
    static constexpr bool PERM = true, AFTER_DRAIN = false, TWO_SEG = false;
    bf16_t *QN, *QR; const float* SSQ; const float *cosT, *sinT;
    __device__ __forceinline__ void operator()(const Acc& acc, const pg8::Unit& u, int, int, int, int) const {
        const int tid_ = opaque_tid(), wid_ = tid_ >> 6, wr = wid_ >> 2, wc = wid_ & 3, fr = tid_ & 15, fq = (tid_ >> 4) & 3;
        const int pn = u.pn, row0 = u.pm * 256 + wr * 64 + fr, cw = wc * 32 + 8 * fq;
        EPI_LOOP_AM { const int row = row0 + ai * 128 + m * 16;
            const f32x4 q0 = *(const f32x4*)(SSQ + (size_t)row * 12), q1 = *(const f32x4*)(SSQ + (size_t)row * 12 + 4);
            const float rstd = rsqrtf(((q0[0] + q0[1]) + (q0[2] + q0[3]) + (q1[0] + q1[1]) + (q1[2] + q1[3])) * (1.f / 512.f) + EPS);
            if (pn < 4) {
#pragma unroll
                for (int bj = 0; bj < 2; ++bj) *(u32x4*)(QN + (size_t)row * 1024 + pn * 256 + bj * 128 + cw) = pack8u(acc[ai][bj][m][0] * rstd, acc[ai][bj][m][1] * rstd);
            } else {
                const int head = 4 * (pn - 4) + wc;
                const f32x4 c0 = *(const f32x4*)(cosT + (size_t)row * 32 + 8 * fq), c1 = *(const f32x4*)(cosT + (size_t)row * 32 + 8 * fq + 4);
                const f32x4 s0 = *(const f32x4*)(sinT + (size_t)row * 32 + 8 * fq), s1 = *(const f32x4*)(sinT + (size_t)row * 32 + 8 * fq + 4);
                const f32x4 a0 = acc[ai][0][m][0] * rstd, a1 = acc[ai][0][m][1] * rstd, b0 = acc[ai][1][m][0] * rstd, b1 = acc[ai][1][m][1] * rstd;
                *(u32x4*)(QR + (size_t)row * 512 + head * 64 + 8 * fq) = pack8u(a0 * c0 - b0 * s0, a1 * c1 - b1 * s1);
                *(u32x4*)(QR + (size_t)row * 512 + head * 64 + 32 + 8 * fq) = pack8u(a0 * s0 + b0 * c0, a1 * s1 + b1 * c1);
            } }
    }
};

struct EpiKV {
    static constexpr bool PERM = true, AFTER_DRAIN = false, TWO_SEG = false;
    bf16_t *KN, *V; const float* SSQ;
    __device__ __forceinline__ void operator()(const Acc& acc, const pg8::Unit& u, int, int, int, int) const {
        const int tid_ = opaque_tid(), wid_ = tid_ >> 6, wr = wid_ >> 2, wc = wid_ & 3, fr = tid_ & 15, fq = (tid_ >> 4) & 3;
        const int pn = u.pn, row0 = u.pm * 256 + wr * 64 + fr, cw = wc * 32 + 8 * fq;
        EPI_LOOP_AM { const int row = row0 + ai * 128 + m * 16;
            const f32x4 q0 = *(const f32x4*)(SSQ + (size_t)row * 12 + 8);
            const float rstd = rsqrtf(((q0[0] + q0[1]) + (q0[2] + q0[3])) * (1.f / 256.f) + EPS);
            *(u32x4*)(KN + (size_t)row * 1024 + pn * 128 + cw) = pack8u(acc[ai][0][m][0] * rstd, acc[ai][0][m][1] * rstd);
            *(u32x4*)(V + (size_t)row * 1024 + pn * 128 + cw) = pack8u(acc[ai][1][m][0] * rstd, acc[ai][1][m][1] * rstd); }
    }
};

template <int SECOND> struct EpiMix {
    static constexpr bool PERM = true, AFTER_DRAIN = false, TWO_SEG = false;
    bf16_t* MX; const bf16_t* G;
    __device__ __forceinline__ void operator()(const Acc& acc, const pg8::Unit& u, int, int, int, int) const {
        const int tid_ = opaque_tid(), wid_ = tid_ >> 6, wr = wid_ >> 2, wc = wid_ & 3, fr = tid_ & 15, fq = (tid_ >> 4) & 3;
        const int row0 = u.pm * 256 + wr * 64 + fr, col0 = u.pn * 256 + wc * 32 + 8 * fq;
        EPI_LOOP_AM { const int row = row0 + ai * 128 + m * 16;
#pragma unroll
            for (int bj = 0; bj < 2; ++bj) { const size_t off = (size_t)row * 2048 + col0 + bj * 128;
                const u32x4 gw = *(const u32x4*)(G + off);
                f32x4 v0 = acc[ai][bj][m][0], v1 = acc[ai][bj][m][1];
                v0[0] *= bf_lo(gw[0]); v0[1] *= bf_hi(gw[0]); v0[2] *= bf_lo(gw[1]); v0[3] *= bf_hi(gw[1]);
                v1[0] *= bf_lo(gw[2]); v1[1] *= bf_hi(gw[2]); v1[2] *= bf_lo(gw[3]); v1[3] *= bf_hi(gw[3]);
                if (SECOND) { const u32x4 pw = *(const u32x4*)(MX + off);
                    v0[0] += bf_lo(pw[0]); v0[1] += bf_hi(pw[0]); v0[2] += bf_lo(pw[1]); v0[3] += bf_hi(pw[1]);
                    v1[0] += bf_lo(pw[2]); v1[1] += bf_hi(pw[2]); v1[2] += bf_lo(pw[3]); v1[3] += bf_hi(pw[3]); }
                *(u32x4*)(MX + off) = pack8u(v0, v1); } }
    }
};

struct EpiMix2 {
    static constexpr bool PERM = true, AFTER_DRAIN = false, TWO_SEG = true;
    bf16_t* MX; const bf16_t* GA; const bf16_t* GB;
    __device__ __forceinline__ void mid(Acc& acc, const pg8::Unit& u, int, int, int, int) const {
        const int tid_ = opaque_tid(), wid_ = tid_ >> 6, wr = wid_ >> 2, wc = wid_ & 3, fr = tid_ & 15, fq = (tid_ >> 4) & 3;
        const int row0 = u.pm * 256 + wr * 64 + fr, col0 = u.pn * 256 + wc * 32 + 8 * fq;
        EPI_LOOP_AM { const int row = row0 + ai * 128 + m * 16;
#pragma unroll
            for (int bj = 0; bj < 2; ++bj) { const size_t off = (size_t)row * 2048 + col0 + bj * 128;
                const u32x4 ga = *(const u32x4*)(GA + off), gb = *(const u32x4*)(GB + off);
                f32x4& v0 = acc[ai][bj][m][0]; f32x4& v1 = acc[ai][bj][m][1];
                v0[0] *= bf_lo(ga[0]) / bf_lo(gb[0]); v0[1] *= bf_hi(ga[0]) / bf_hi(gb[0]); v0[2] *= bf_lo(ga[1]) / bf_lo(gb[1]); v0[3] *= bf_hi(ga[1]) / bf_hi(gb[1]);
                v1[0] *= bf_lo(ga[2]) / bf_lo(gb[2]); v1[1] *= bf_hi(ga[2]) / bf_hi(gb[2]); v1[2] *= bf_lo(ga[3]) / bf_lo(gb[3]); v1[3] *= bf_hi(ga[3]) / bf_hi(gb[3]); } }
    }
    __device__ __forceinline__ void operator()(const Acc& acc, const pg8::Unit& u, int, int, int, int) const {
        const int tid_ = opaque_tid(), wid_ = tid_ >> 6, wr = wid_ >> 2, wc = wid_ & 3, fr = tid_ & 15, fq = (tid_ >> 4) & 3;
        const int row0 = u.pm * 256 + wr * 64 + fr, col0 = u.pn * 256 + wc * 32 + 8 * fq;
        EPI_LOOP_AM { const int row = row0 + ai * 128 + m * 16;
#pragma unroll
            for (int bj = 0; bj < 2; ++bj) { const size_t off = (size_t)row * 2048 + col0 + bj * 128;
                const u32x4 gb = *(const u32x4*)(GB + off);
                f32x4 v0 = acc[ai][bj][m][0], v1 = acc[ai][bj][m][1];
                v0[0] *= bf_lo(gb[0]); v0[1] *= bf_hi(gb[0]); v0[2] *= bf_lo(gb[1]); v0[3] *= bf_hi(gb[1]);
                v1[0] *= bf_lo(gb[2]); v1[1] *= bf_hi(gb[2]); v1[2] *= bf_lo(gb[3]); v1[3] *= bf_hi(gb[3]);
                v0 = v0 * MX8_SCALE; v1 = v1 * MX8_SCALE;
#pragma unroll
                for (int e = 0; e < 4; ++e) { v0[e] = fminf(fmaxf(v0[e], -448.f), 448.f); v1[e] = fminf(fmaxf(v1[e], -448.f), 448.f); }
                int p0 = 0, p1 = 0;
                p0 = __builtin_amdgcn_cvt_pk_fp8_f32(v0[0], v0[1], p0, false); p0 = __builtin_amdgcn_cvt_pk_fp8_f32(v0[2], v0[3], p0, true);
                p1 = __builtin_amdgcn_cvt_pk_fp8_f32(v1[0], v1[1], p1, false); p1 = __builtin_amdgcn_cvt_pk_fp8_f32(v1[2], v1[3], p1, true);
                *(u32x2*)((unsigned char*)MX + off) = (u32x2){(unsigned)p0, (unsigned)p1}; } }
    }
};
struct EpiY {
    static constexpr bool PERM = true, AFTER_DRAIN = false, TWO_SEG = false;
    bf16_t* Y; float sc;
    __device__ __forceinline__ void operator()(const Acc& acc, const pg8::Unit& u, int, int, int, int) const {
        const int tid_ = opaque_tid(), wid_ = tid_ >> 6, wr = wid_ >> 2, wc = wid_ & 3, fr = tid_ & 15, fq = (tid_ >> 4) & 3;
        const int row0 = u.pm * 256 + wr * 64 + fr, col0 = u.pn * 256 + wc * 32 + 8 * fq;
        EPI_LOOP_AM { const int row = row0 + ai * 128 + m * 16;
#pragma unroll
            for (int bj = 0; bj < 2; ++bj) *(u32x4*)(Y + (size_t)row * 2048 + col0 + bj * 128) = pack8u(acc[ai][bj][m][0] * sc, acc[ai][bj][m][1] * sc); }
    }
};
struct EpiRes {
    static constexpr bool PERM = false, AFTER_DRAIN = false, TWO_SEG = false;
    const float* base; float* out;
    __device__ __forceinline__ void operator()(const Acc& acc, const pg8::Unit& u, int, int, int, int) const {
        const int tid_ = opaque_tid(), wid_ = tid_ >> 6, wr = wid_ >> 2, wc = wid_ & 3, fr = tid_ & 15, fq = (tid_ >> 4) & 3;
        const int row0 = u.pm * 256 + wr * 64 + fr, col0 = u.pn * 256 + wc * 32 + 4 * fq;
        EPI_LOOP_AM { const int row = row0 + ai * 128 + m * 16;
#pragma unroll
            for (int bj = 0; bj < 2; ++bj)
#pragma unroll
                for (int n = 0; n < 2; ++n) { const size_t off = (size_t)row * 2048 + col0 + bj * 128 + n * 16;
                    *(f32x4*)(out + off) = *(const f32x4*)(base + off) + acc[ai][bj][m][n]; } }
    }
};
struct EpiF32 {
    static constexpr bool PERM = false, AFTER_DRAIN = false, TWO_SEG = false;
    float* out;
    __device__ __forceinline__ void operator()(const Acc& acc, const pg8::Unit& u, int, int, int, int) const {
        const int tid_ = opaque_tid(), wid_ = tid_ >> 6, wr = wid_ >> 2, wc = wid_ & 3, fr = tid_ & 15, fq = (tid_ >> 4) & 3;
        const int row0 = u.pm * 256 + wr * 64 + fr, col0 = u.pn * 256 + wc * 32 + 4 * fq;
        EPI_LOOP_AM { const int row = row0 + ai * 128 + m * 16;
#pragma unroll
            for (int bj = 0; bj < 2; ++bj)
#pragma unroll
                for (int n = 0; n < 2; ++n) *(f32x4*)(out + (size_t)row * 2048 + col0 + bj * 128 + n * 16) = acc[ai][bj][m][n]; }
    }
};

namespace mla {
constexpr int NW = 8, QBLK = 32, KVBLK = 64, QB = NW * QBLK;
constexpr int SHM_V = KVBLK * 128 * 2, SHM_KN = KVBLK * 128 * 2, SHM_KR = KVBLK * 64 * 2;
constexpr int OFF_V = 0, OFF_KN = 2 * SHM_V, OFF_KR = OFF_KN + 2 * SHM_KN, OFF_WS = OFF_KR + 2 * SHM_KR, OFF_QR = OFF_WS + NW * 64 * 4, LDS_BYTES = OFF_QR + NW * 4096;
constexpr float SCALE = 0.07216878364870322f;
constexpr float THR = 8.f;
constexpr int LQN = 1024, LQR = 512, LKN = 1024, LKR = 64, LV = 1024, LO = 1024;
#define KSWZ(row, colB) ((row) * 256 + ((colB) ^ (((row) & 7) << 4)))
#define KRSWZ(row, colB) ((row) * 128 + ((colB) ^ (((row) & 7) << 4)))
#define SBAR() __builtin_amdgcn_sched_barrier(0)
__device__ __forceinline__ int v_st(int k, int c) { const int kk = (k & ~0xC) | ((k & 4) << 1) | ((k & 8) >> 1); return ((kk >> 3) * 4 + (c >> 5)) * 512 + ((kk & 7) * 32 + (c & 31)) * 2; }
__device__ __forceinline__ int v_rd_base(int lane) { return ((lane & 3) << 3) | (((lane >> 2) & 3) << 6) | (((lane >> 4) & 1) << 5) | (((lane >> 5) & 1) << 8); }
constexpr int v_rd_off(int d0, int ks, int half) { return d0 * 512 + ks * 4096 + half * 2048; }
__device__ __forceinline__ int crow(int r, int hi) { return (r & 3) + 8 * (r >> 2) + 4 * hi; }
__device__ __forceinline__ bf16x8 load8(const bf16_t* p) { return *reinterpret_cast<const bf16x8*>(p); }
__device__ __forceinline__ void mask_tile(f32x16& p0, f32x16& p1, int dq, unsigned W) {
    const float NEG = -__builtin_inff();
#pragma unroll
    for (int r = 0; r < 16; ++r) {
        const int c = (r & 3) + 8 * (r >> 2);
        if ((unsigned)(dq - c) >= W) p0[r] = NEG;
        if ((unsigned)(dq - c - 32) >= W) p1[r] = NEG;
    }
}
__device__ __forceinline__ void partialSM(f32x16& p0, f32x16& p1, float& m_reg, float& mn, float& alpha) {
    float pmax = p0[0];
#pragma unroll
    for (int r = 1; r < 16; ++r) pmax = fmaxf(pmax, p0[r]);
#pragma unroll
    for (int r = 0; r < 16; ++r) pmax = fmaxf(pmax, p1[r]);
    { auto rr = __builtin_amdgcn_permlane32_swap(__float_as_uint(pmax), __float_as_uint(pmax), false, false);
      pmax = fmaxf(__uint_as_float(rr[0]), __uint_as_float(rr[1])); }
    constexpr float C2 = 1.4426950408889634f * SCALE;
    if (__builtin_expect(__all((pmax - m_reg) * SCALE <= THR), 1)) { mn = m_reg; alpha = 1.f; }
    else { mn = fmaxf(m_reg, pmax); alpha = __builtin_amdgcn_exp2f((m_reg - mn) * C2); m_reg = mn; }
    const float mnL = -mn * C2;
#pragma unroll
    for (int r = 0; r < 16; ++r) p0[r] = fmaf(p0[r], C2, mnL);
#pragma unroll
    for (int r = 0; r < 16; ++r) p1[r] = fmaf(p1[r], C2, mnL);
#pragma unroll
    for (int r = 0; r < 16; ++r) p0[r] = __builtin_amdgcn_exp2f(p0[r]);
}
__device__ __forceinline__ void finishSM(f32x16& p0, f32x16& p1, float alpha, float& l_reg, bf16x8& pa0, bf16x8& pa1, bf16x8& pa2, bf16x8& pa3) {
#pragma unroll
    for (int r = 0; r < 16; ++r) p1[r] = __builtin_amdgcn_exp2f(p1[r]);
    float ps = 0;
#pragma unroll
    for (int r = 0; r < 16; ++r) ps += p0[r];
#pragma unroll
    for (int r = 0; r < 16; ++r) ps += p1[r];
    { auto rr = __builtin_amdgcn_permlane32_swap(__float_as_uint(ps), __float_as_uint(ps), false, false);
      ps = __uint_as_float(rr[0]) + __uint_as_float(rr[1]); }
    l_reg = l_reg * alpha + ps;
#define PK4(P, B_, OUT) do { unsigned a0 = cvt_pk_bf16(P[B_+0], P[B_+1]), a1 = cvt_pk_bf16(P[B_+2], P[B_+3]);                          \
        unsigned b0 = cvt_pk_bf16(P[B_+4], P[B_+5]), b1 = cvt_pk_bf16(P[B_+6], P[B_+7]);                                             \
        auto r0 = __builtin_amdgcn_permlane32_swap(a0, b0, false, false); auto r1 = __builtin_amdgcn_permlane32_swap(a1, b1, false, false); \
        u32x4 w = {r0[0], r1[0], r0[1], r1[1]}; OUT = *reinterpret_cast<bf16x8*>(&w); } while (0)
    PK4(p0, 0, pa0); PK4(p0, 8, pa1); PK4(p1, 0, pa2); PK4(p1, 8, pa3);
#undef PK4
}
template <int KB>
__device__ __forceinline__ void qkt(f32x16& p0, f32x16& p1, const char* lds, int r32, int hi, const bf16x8* qr, const char* qrl) {
    p0 = f32x16{}; p1 = f32x16{};
    const char* kb[4]; const char* rb[4];
#pragma unroll
    for (int dd = 0; dd < 4; ++dd) { kb[dd] = lds + OFF_KN + KB * SHM_KN + KSWZ(r32, (dd * 16 + hi * 8) * 2); rb[dd] = lds + OFF_KR + KB * SHM_KR + KRSWZ(r32, (dd * 16 + hi * 8) * 2); }
#pragma unroll
    for (int d0 = 0; d0 < 8; ++d0) { const char* a = kb[d0 & 3] + (d0 >> 2) * 128;
        bf16x8 b0 = *reinterpret_cast<const bf16x8*>(a);
        bf16x8 b1 = *reinterpret_cast<const bf16x8*>(a + 32 * 256);
        p0 = __builtin_amdgcn_mfma_f32_32x32x16_bf16(b0, qr[d0], p0, 0, 0, 0);
        p1 = __builtin_amdgcn_mfma_f32_32x32x16_bf16(b1, qr[d0], p1, 0, 0, 0); }
#pragma unroll
    for (int d0 = 0; d0 < 4; ++d0) { const char* a = rb[d0];
        bf16x8 b0 = *reinterpret_cast<const bf16x8*>(a);
        bf16x8 b1 = *reinterpret_cast<const bf16x8*>(a + 32 * 128);
        const bf16x8 qf = *reinterpret_cast<const bf16x8*>(qrl + d0 * 1024);
        p0 = __builtin_amdgcn_mfma_f32_32x32x16_bf16(b0, qf, p0, 0, 0, 0);
        p1 = __builtin_amdgcn_mfma_f32_32x32x16_bf16(b1, qf, p1, 0, 0, 0); }
}
template <int VB>
__device__ __forceinline__ void pv_tile(f32x16* o, int vb0, bf16x8 pa0, bf16x8 pa1, bf16x8 pa2, bf16x8 pa3) {
#define TRRD(dst, off) asm volatile("ds_read_b64_tr_b16 %0, %1 offset:%2" : "=&v"(dst) : "v"(vb0), "i"(off) : "memory")
#define PV_D0(d0) do { s16x4 l0, l1, l2, l3, h0, h1, h2, h3; constexpr int b_ = OFF_V + VB * SHM_V + v_rd_off(d0, 0, 0); \
        TRRD(l0, b_); TRRD(h0, b_ + 2048); TRRD(l1, b_ + 4096); TRRD(h1, b_ + 6144); TRRD(l2, b_ + 8192); TRRD(h2, b_ + 10240); TRRD(l3, b_ + 12288); TRRD(h3, b_ + 14336); \
        asm volatile("s_waitcnt lgkmcnt(0)" ::: "memory"); SBAR();   \
        o[d0] = __builtin_amdgcn_mfma_f32_32x32x16_bf16(pa0, (bf16x8){l0[0], l0[1], l0[2], l0[3], h0[0], h0[1], h0[2], h0[3]}, o[d0], 0, 0, 0);   \
        o[d0] = __builtin_amdgcn_mfma_f32_32x32x16_bf16(pa1, (bf16x8){l1[0], l1[1], l1[2], l1[3], h1[0], h1[1], h1[2], h1[3]}, o[d0], 0, 0, 0);   \
        o[d0] = __builtin_amdgcn_mfma_f32_32x32x16_bf16(pa2, (bf16x8){l2[0], l2[1], l2[2], l2[3], h2[0], h2[1], h2[2], h2[3]}, o[d0], 0, 0, 0);   \
        o[d0] = __builtin_amdgcn_mfma_f32_32x32x16_bf16(pa3, (bf16x8){l3[0], l3[1], l3[2], l3[3], h3[0], h3[1], h3[2], h3[3]}, o[d0], 0, 0, 0); } while (0)
    PV_D0(0); PV_D0(1); PV_D0(2); PV_D0(3);
#undef PV_D0
#undef TRRD
}
struct BlockRef { const bf16_t* Qn; const bf16_t* Qr; const bf16_t* Kn; const bf16_t* Kr; const bf16_t* V; bf16_t* O; int P0; };
struct Seam { bf16x8 qr[8]; bf16x8 st_v0, st_v1, st_k0, st_k1, st_kr; };
#define VMW() asm volatile("s_waitcnt vmcnt(0)" ::: "memory")
#define VMWN(n) asm volatile("s_waitcnt vmcnt(%0)" :: "i"(n) : "memory")
#define UB(p) ((const char*)(p))
#define UNI(p) uni_ptr((const void*)(p))
#define SLOAD_H(R, k0) do { const char* vb_ = UNI((R).V + (size_t)(k0) * LV); const char* kb_ = UNI((R).Kn + (size_t)(k0) * LKN); const char* rb_ = UNI((R).Kr + (size_t)(k0) * LKR); \
                            S.st_v0 = *(const bf16x8*)(vb_ + voffA); S.st_v1 = *(const bf16x8*)(vb_ + voffB); \
                            S.st_k0 = *(const bf16x8*)(kb_ + voffA); S.st_k1 = *(const bf16x8*)(kb_ + voffB); \
                            S.st_kr = *(const bf16x8*)(rb_ + voffR); } while (0)
#define SWRITE_HK(bf) do { *(bf16x8*)(lds + OFF_KN + (bf) * SHM_KN + kws) = S.st_k0; *(bf16x8*)(lds + OFF_KN + (bf) * SHM_KN + kws + 32 * 256) = S.st_k1; \
                           *(bf16x8*)(lds + OFF_KR + (bf) * SHM_KR + krws) = S.st_kr; } while (0)
#define SWRITE_HV(bf) do { *(bf16x8*)(lds + OFF_V + (bf) * SHM_V + vst0) = S.st_v0; *(bf16x8*)(lds + OFF_V + (bf) * SHM_V + vst1) = S.st_v1; } while (0)
#define SWRITE_H(bf) do { SWRITE_HV(bf); SWRITE_HK(bf); } while (0)
#define QLOAD(R) do { _Pragma("unroll") for (int d0 = 0; d0 < 8; ++d0) S.qr[d0] = *(const bf16x8*)(UB((R).Qn) + voffQ + d0 * 32); } while (0)
__device__ __forceinline__ void block(const BlockRef& cur, char* lds) {
    const int tid = opaque_tid(), wid = __builtin_amdgcn_readfirstlane(tid >> 6), lane = tid & 63, r32 = lane & 31, hi = lane >> 5;
    constexpr int W = 1 << 30;
    const int NT = (cur.P0 + QB - 1) / KVBLK + 1;
    const int qlo = cur.P0 + wid * QBLK, qm = qlo + r32 - 4 * hi;
    float* ws = (float*)(lds + OFF_WS) + wid * 64; float* li_l = ws, * al_l = ws + 32;
    float m_reg = -1e30f, l_reg = 0; f32x16 o[4] = {};
    const int sr = tid >> 4, sc = (tid & 15) * 8, vst0 = v_st(sr, sc), vst1 = v_st(32 + sr, sc), kws = KSWZ(sr, sc * 2);
    const int kr_r = tid >> 3, kr_c = (tid & 7) * 8, krws = KRSWZ(kr_r, kr_c * 2);
    const int vb0 = (int)(uintptr_t)lds + v_rd_base(lane);
    char* qrl = lds + OFF_QR + wid * 4096 + lane * 16;
    const unsigned voffA = (unsigned)(sr * LV + sc) * 2u, voffB = voffA + 32u * LV * 2u, voffR = (unsigned)(kr_r * LKR + kr_c) * 2u;
    const unsigned voffQ = (unsigned)((wid * QBLK + r32) * LQN + hi * 8) * 2u, voffQr = (unsigned)((wid * QBLK + r32) * LQR + hi * 8) * 2u;
    Seam S;
    { bf16x8 tq[4];
#pragma unroll
      for (int d0 = 0; d0 < 4; ++d0) tq[d0] = *(const bf16x8*)(UB(cur.Qr) + voffQr + d0 * 32);
      QLOAD(cur);
      SLOAD_H(cur, 0);
#pragma unroll
      for (int d0 = 0; d0 < 4; ++d0) *reinterpret_cast<bf16x8*>(qrl + d0 * 1024) = tq[d0]; }
    VMW(); SWRITE_H(0);
    __syncthreads();
#define RESC(a) do { if (__any((a) < 1.f)) { if (hi == 0) al_l[r32] = (a); asm volatile("s_waitcnt lgkmcnt(0)" ::: "memory");              \
                     _Pragma("unroll") for (int d_ = 0; d_ < 4; ++d_) _Pragma("unroll") for (int r = 0; r < 16; ++r) o[d_][r] *= al_l[crow(r, hi)]; } } while (0)
#define KBASE(t) ((t) * KVBLK)
#define MASKT(P0_, P1_, t) do { const int kb_ = KBASE(t); if (kb_ + KVBLK - 1 > qlo) mask_tile(P0_, P1_, qm - kb_, (unsigned)W); } while (0)
    f32x16 pA0, pA1, pB0, pB1; float mnA, mnB, alA, alB; bf16x8 pa0, pa1, pa2, pa3;
    if (NT > 1) { SLOAD_H(cur, KBASE(1)); }
    SBAR(); qkt<0>(pA0, pA1, lds, r32, hi, S.qr, qrl);
    MASKT(pA0, pA1, 0); partialSM(pA0, pA1, m_reg, mnA, alA);
    if (NT > 1) { VMW(); SWRITE_H(1); }
    __syncthreads();
#define HALF_STEP(PX0, PX1, mnX, alX, PY0, PY1, alY, t, KB, VB, SB) do {                                                      \
        SBAR(); qkt<KB>(PX0, PX1, lds, r32, hi, S.qr, qrl);                                             \
        finishSM(PY0, PY1, alY, l_reg, pa0, pa1, pa2, pa3); SBAR();                                                           \
        if ((t) + 1 < NT) { SLOAD_H(cur, KBASE((t) + 1)); SBAR(); }                                               \
        pv_tile<VB>(o, vb0, pa0, pa1, pa2, pa3); MASKT(PX0, PX1, (t)); partialSM(PX0, PX1, m_reg, mnX, alX);                                        \
        __syncthreads();                                                                                                      \
        if ((t) + 1 < NT) { VMW(); SWRITE_H(SB); }                                                                          \
        RESC(alX); __syncthreads(); } while (0)
    for (int t = 1; t + 1 < NT; t += 2) {
        HALF_STEP(pB0, pB1, mnB, alB, pA0, pA1, alA, t, 1, 0, 0);
        HALF_STEP(pA0, pA1, mnA, alA, pB0, pB1, alB, t + 1, 0, 1, 1);
    }
    const bool even = (NT & 1) == 0;
    if (even) { SBAR(); qkt<1>(pB0, pB1, lds, r32, hi, S.qr, qrl); SBAR(); }
    finishSM(pA0, pA1, alA, l_reg, pa0, pa1, pa2, pa3); SBAR();
    pv_tile<0>(o, vb0, pa0, pa1, pa2, pa3);
    if (even) { MASKT(pB0, pB1, NT - 1); partialSM(pB0, pB1, m_reg, mnB, alB); __syncthreads(); RESC(alB);
        finishSM(pB0, pB1, alB, l_reg, pa0, pa1, pa2, pa3); SBAR(); pv_tile<1>(o, vb0, pa0, pa1, pa2, pa3); }
    SBAR();
    if (hi == 0) li_l[r32] = l_reg; asm volatile("s_waitcnt lgkmcnt(0)" ::: "memory");
    float rli[16];
#pragma unroll
    for (int r = 0; r < 16; ++r) rli[r] = __builtin_amdgcn_rcpf(li_l[crow(r, hi)]);
    const unsigned voffO = (unsigned)((wid * QBLK + 4 * hi) * LO + r32) * 2u;
#pragma unroll
    for (int r = 0; r < 16; ++r) { const int orow8 = (r & 3) + 8 * (r >> 2);
#pragma unroll
        for (int d0 = 0; d0 < 4; ++d0) { const float v = o[d0][r] * rli[r];
            const float vn = __shfl_xor(v, 1);
            if ((r32 & 1) == 0) *(unsigned*)((char*)cur.O + voffO + (orow8 * LO + d0 * 32) * 2) = cvt_pk_bf16(v, vn); } }
    __syncthreads();
#undef RESC
#undef KBASE
#undef MASKT
#undef HALF_STEP
}
#undef VMW
#undef VMWN
#undef SLOAD_H
#undef UB
#undef UNI
#undef SWRITE_HK
#undef SWRITE_HV
#undef SWRITE_H
#undef QLOAD
__device__ __forceinline__ BlockRef make_ref(int bh, int qb, const bf16_t* QN, const bf16_t* QR, const bf16_t* KN, const bf16_t* KR, const bf16_t* V, bf16_t* O) {
    const int b = bh >> 3, h = bh & 7; const size_t rb = (size_t)b * SEQ, q0 = rb + (size_t)qb * QB;
    BlockRef r; r.Qn = QN + q0 * LQN + h * 128; r.Qr = QR + q0 * LQR + h * 64; r.Kn = KN + rb * LKN + h * 128; r.Kr = KR + rb * LKR; r.V = V + rb * LV + h * 128;
    r.O = O + q0 * LO + h * 128; r.P0 = qb * QB; return r;
}
__device__ __forceinline__ void phase(char* lds, int vcu, int G, const bf16_t* QN, const bf16_t* QR, const bf16_t* KN, const bf16_t* KR, const bf16_t* V, bf16_t* O) {
    constexpr int NITEM = BATCH * 8 * 16;
    for (int L = vcu; L < NITEM; L += G) {
#pragma unroll 1
        for (int pass = 0; pass < 2; ++pass) {
            const int qb = pass == 0 ? (L & 15) : 31 - (L & 15);
            const BlockRef cur = make_ref(L >> 4, qb, QN, QR, KN, KR, V, O);
            block(cur, lds);
        }
    }
}
#undef KSWZ
#undef KRSWZ
#undef SBAR
}

namespace swa {
constexpr int K_OFF = 0, VT_OFF = 32768, VT_PITCH = 544, POS_OFF = VT_OFF + 64 * VT_PITCH, LDS_BYTES = POS_OFF + 1024;
__device__ __forceinline__ void unit(int u, const bf16_t* QA, const bf16_t* KA, const bf16_t* VA, bf16_t* AA, const int* pos, const float* sinks, char* lds) {
    const int tid = opaque_tid(), lane = tid & 63, wid = __builtin_amdgcn_readfirstlane(tid >> 6), r16 = lane & 15, g4 = lane >> 4;
    const int b = u >> 8, n = (u & 255) >> 2, kvh = u & 3;
    const int rowbase = b * SEQ, qrow0 = rowbase + n * 128, krow0 = qrow0 - 128;
    __syncthreads();
#pragma unroll
    for (int i = 0; i < 4; ++i) { const int id = tid + 512 * i, key = id >> 3, ch = id & 7; const bool valid = (n > 0) || (key >= 128);
        unsigned z_ = 0u; asm volatile("" : "+v"(z_)); u32x4 kv = {z_, z_, z_, z_}, vv = {z_, z_, z_, z_};
        if (valid) { kv = *(const u32x4*)(KA + (size_t)(krow0 + key) * 256 + kvh * 64 + ch * 8); vv = *(const u32x4*)(VA + (size_t)(krow0 + key) * 256 + kvh * 64 + ch * 8); }
        *(u32x4*)(lds + K_OFF + key * 128 + ((ch ^ (key & 7)) << 4)) = kv;
#pragma unroll
        for (int j = 0; j < 4; ++j) { *(unsigned short*)(lds + VT_OFF + (ch * 8 + 2 * j) * VT_PITCH + key * 2) = (unsigned short)(vv[j] & 0xffffu);
                                      *(unsigned short*)(lds + VT_OFF + (ch * 8 + 2 * j + 1) * VT_PITCH + key * 2) = (unsigned short)(vv[j] >> 16); } }
    if (tid < 256) { int kidx = krow0 + tid; if (kidx < rowbase) kidx = rowbase; *(float*)(lds + POS_OFF + tid * 4) = (float)pos[kidx]; }
    if (tid < 128) { unsigned z_ = 0u; asm volatile("" : "+v"(z_)); *(u32x4*)(lds + VT_OFF + (tid >> 1) * VT_PITCH + 512 + (tid & 1) * 16) = (u32x4){z_, z_, z_, z_}; }
    __syncthreads();
    const int qt = wid, qi = 16 * qt + r16;
    const float pqf = (float)pos[qrow0 + qi];
    const char* kb0 = lds + K_OFF + qt * 2048 + r16 * 128 + ((g4 ^ (r16 & 7)) << 4);
    const char* kb1 = lds + K_OFF + qt * 2048 + r16 * 128 + (((g4 + 4) ^ (r16 & 7)) << 4);
    const char* vb = lds + VT_OFF + r16 * VT_PITCH + (qt * 16 + 4 * g4) * 2;
    const char* pb = lds + POS_OFF + (qt * 16 + 4 * g4) * 4;
    const int relb = 128 + qi - (qt * 16 + 4 * g4);
    const int kjb = qt * 16 + 4 * g4;
    float dm[9][4];
#pragma unroll
    for (int i = 0; i < 9; ++i) { const f32x4 pk = *(const f32x4*)(pb + i * 64);
#pragma unroll
        for (int rg = 0; rg < 4; ++rg) { const int rel = relb - 16 * i - rg; const bool v = ((unsigned)rel < 128u) && (n > 0 || kjb + 16 * i + rg >= 128); dm[i][rg] = v ? fabsf(pqf - pk[rg]) : 1e30f; } }
    constexpr float L2E = 1.4426950408889634f;
#pragma unroll 1
    for (int g = 0; g < 4; ++g) {
        const int h = kvh * 4 + g;
        const float nslope = -L2E * exp2f(-0.5f * (float)(h + 1)), sink = sinks[h] * L2E;
        const bf16_t* qp = QA + (size_t)(qrow0 + qi) * 1024 + h * 64 + 8 * g4;
        const bf16x8 bq0 = *(const bf16x8*)qp, bq1 = *(const bf16x8*)(qp + 32);
        f32x4 s[10]; float mx = -1e30f;
#pragma unroll
        for (int i = 0; i < 9; ++i) {
            const bf16x8 a0 = *(const bf16x8*)(kb0 + i * 2048), a1 = *(const bf16x8*)(kb1 + i * 2048);
            f32x4 c = {0.f, 0.f, 0.f, 0.f};
            c = __builtin_amdgcn_mfma_f32_16x16x32_bf16(a0, bq0, c, 0, 0, 0);
            c = __builtin_amdgcn_mfma_f32_16x16x32_bf16(a1, bq1, c, 0, 0, 0);
#pragma unroll
            for (int rg = 0; rg < 4; ++rg) { const float lg = fmaf(c[rg], 0.125f * L2E, nslope * dm[i][rg]); c[rg] = lg; mx = fmaxf(mx, lg); }
            s[i] = c;
            if (i % 3 == 2) __builtin_amdgcn_sched_barrier(0);
        }
        s[9] = (f32x4){0.f, 0.f, 0.f, 0.f};
        mx = fmaxf(mx, __shfl_xor(mx, 16)); mx = fmaxf(mx, __shfl_xor(mx, 32)); mx = fmaxf(mx, sink);
        float sum = 0.f;
#pragma unroll
        for (int i = 0; i < 9; ++i)
#pragma unroll
            for (int rg = 0; rg < 4; ++rg) { const float p = __builtin_amdgcn_exp2f(s[i][rg] - mx); s[i][rg] = p; sum += p; }
        sum += __shfl_xor(sum, 16); sum += __shfl_xor(sum, 32);
        const float inv = 1.f / (sum + __builtin_amdgcn_exp2f(sink - mx));
        bf16x8 bp[5];
#pragma unroll
        for (int ks = 0; ks < 5; ++ks) bp[ks] = pack8(s[2 * ks] * inv, s[2 * ks + 1] * inv);
        __builtin_amdgcn_sched_barrier(0);
#pragma unroll
        for (int dt = 0; dt < 4; ++dt) { f32x4 o = {0.f, 0.f, 0.f, 0.f};
#pragma unroll
            for (int ks = 0; ks < 5; ++ks) {
                const u32x2 lo = *(const u32x2*)(vb + dt * 16 * VT_PITCH + ks * 64), hi2 = *(const u32x2*)(vb + dt * 16 * VT_PITCH + ks * 64 + 32);
                const u32x4 aw = {lo[0], lo[1], hi2[0], hi2[1]};
                o = __builtin_amdgcn_mfma_f32_16x16x32_bf16(__builtin_bit_cast(bf16x8, aw), bp[ks], o, 0, 0, 0); }
            u32x2 ow = {cvt_pk_bf16(o[0], o[1]), cvt_pk_bf16(o[2], o[3])};
            *(u32x2*)(AA + (size_t)(qrow0 + qi) * 1024 + h * 64 + dt * 16 + 4 * g4) = ow;
            __builtin_amdgcn_sched_barrier(0); }
    }
}
}

__device__ __forceinline__ void transpose_item_f8(const float* W, int K, int N, unsigned char* WT, int dst_row0, int src_col0, int k0, float scale, LAS float* scr, int lane) {
#pragma unroll 8
    for (int i = 0; i < 32; ++i) { const int kk = 2 * i + (lane >> 5); scr[kk * 33 + (lane & 31)] = W[(size_t)(k0 + kk) * N + src_col0 + (lane & 31)] * scale; }
    asm volatile("s_waitcnt lgkmcnt(0)" ::: "memory");
    const int c = lane & 7;
#pragma unroll
    for (int j = 0; j < 4; ++j) { const int n = (lane >> 3) + 8 * j; const LAS float* sp = scr + (8 * c) * 33 + n;
        int p0 = 0, p1 = 0;
        p0 = __builtin_amdgcn_cvt_pk_fp8_f32(sp[0 * 33], sp[1 * 33], p0, false); p0 = __builtin_amdgcn_cvt_pk_fp8_f32(sp[2 * 33], sp[3 * 33], p0, true);
        p1 = __builtin_amdgcn_cvt_pk_fp8_f32(sp[4 * 33], sp[5 * 33], p1, false); p1 = __builtin_amdgcn_cvt_pk_fp8_f32(sp[6 * 33], sp[7 * 33], p1, true);
        *(u32x2*)(WT + (size_t)(dst_row0 + n) * K + k0 + 8 * c) = (u32x2){(unsigned)p0, (unsigned)p1}; }
    asm volatile("s_waitcnt lgkmcnt(0)" ::: "memory");
}
__device__ __forceinline__ void transpose_item(const float* W, int K, int N, bf16_t* WT, int dst_row0, int src_col0, int k0, const float* gk, LAS float* scr, int lane) {
    if (src_col0 < 0) {
        const int c = lane & 7;
#pragma unroll
        for (int j = 0; j < 4; ++j) { const int n = (lane >> 3) + 8 * j; *(u32x4*)(WT + (size_t)(dst_row0 + n) * K + k0 + 8 * c) = (u32x4){0u, 0u, 0u, 0u}; }
        return;
    }
#pragma unroll 8
    for (int i = 0; i < 32; ++i) { const int kk = 2 * i + (lane >> 5); float v = W[(size_t)(k0 + kk) * N + src_col0 + (lane & 31)]; if (gk) v *= gk[k0 + kk]; scr[kk * 33 + (lane & 31)] = v; }
    asm volatile("s_waitcnt lgkmcnt(0)" ::: "memory");
    const int c = lane & 7;
#pragma unroll
    for (int j = 0; j < 4; ++j) { const int n = (lane >> 3) + 8 * j; const LAS float* s = scr + (8 * c) * 33 + n;
        u32x4 o; o.x = cvt_pk_bf16(s[0 * 33], s[1 * 33]); o.y = cvt_pk_bf16(s[2 * 33], s[3 * 33]); o.z = cvt_pk_bf16(s[4 * 33], s[5 * 33]); o.w = cvt_pk_bf16(s[6 * 33], s[7 * 33]);
        *(u32x4*)(WT + (size_t)(dst_row0 + n) * K + k0 + 8 * c) = o; }
    asm volatile("s_waitcnt lgkmcnt(0)" ::: "memory");
}
__device__ __forceinline__ int win_src(int r0) {
    if (r0 < 2304) return r0;
    if (r0 < 2560) { const int c = r0 - 2304; return c == 0 ? 2304 : (c == 128 ? 2336 : -1); }
    return 2368 + (r0 - 2560);
}
__device__ __forceinline__ int wuq_src(int r0) {
    if (r0 < 1024) return (r0 >> 7) * 192 + (r0 & 127);
    const int rp = r0 - 1024, t = rp >> 8, c = rp & 255, bj = c >> 7, within = c & 127;
    return (4 * t + (within >> 5)) * 192 + 128 + bj * 32;
}
__device__ __forceinline__ void rms_row_bf16(const float* xrow, const float* g, bf16_t* orow, int lane) {
    f32x4 v[8]; float s = 0.f;
#pragma unroll
    for (int j = 0; j < 8; ++j) { v[j] = *(const f32x4*)(xrow + 256 * j + 4 * lane); s += (v[j][0] * v[j][0] + v[j][1] * v[j][1]) + (v[j][2] * v[j][2] + v[j][3] * v[j][3]); }
    const float rstd = rsqrtf(wave_sum(s) * (1.f / DM) + EPS);
#pragma unroll
    for (int j = 0; j < 8; ++j) { const f32x4 gg = *(const f32x4*)(g + 256 * j + 4 * lane); const f32x4 o = v[j] * rstd * gg;
        u32x2 w = {cvt_pk_bf16(o[0], o[1]), cvt_pk_bf16(o[2], o[3])}; *(u32x2*)(orow + 256 * j + 4 * lane) = w; }
}
template <int NR>
__device__ __forceinline__ void rms_rows_bf16(const float* xbase, const bf16_t* ybase  , const float* g, bf16_t* obase, int m0, int mstride, int lane,
                                              unsigned char* xq = nullptr  , float* sx = nullptr  ,
                                              unsigned char* h8 = nullptr  ) {
    f32x4 v[NR][8];
#pragma unroll
    for (int r = 0; r < NR; ++r)
#pragma unroll
        for (int j = 0; j < 8; ++j) v[r][j] = *(const f32x4*)(xbase + (size_t)(m0 + r * mstride) * DM + 256 * j + 4 * lane);
    if (ybase) {
        u32x2 yv[NR][8];
#pragma unroll
        for (int r = 0; r < NR; ++r)
#pragma unroll
            for (int j = 0; j < 8; ++j) yv[r][j] = *(const u32x2*)(ybase + (size_t)(m0 + r * mstride) * DM + 256 * j + 4 * lane);
#pragma unroll
        for (int r = 0; r < NR; ++r)
#pragma unroll
            for (int j = 0; j < 8; ++j) { v[r][j][0] += bf_lo(yv[r][j][0]); v[r][j][1] += bf_hi(yv[r][j][0]); v[r][j][2] += bf_lo(yv[r][j][1]); v[r][j][3] += bf_hi(yv[r][j][1]); }
    }
#pragma unroll
    for (int r = 0; r < NR; ++r) { float s = 0.f;
        f32x4 gg[8];
        { const float* gp = g + 4 * lane; asm volatile("" : "+v"(gp));
#pragma unroll
          for (int j = 0; j < 8; ++j) gg[j] = *(const f32x4*)(gp + 256 * j); }
#pragma unroll
        for (int j = 0; j < 8; ++j) s += (v[r][j][0] * v[r][j][0] + v[r][j][1] * v[r][j][1]) + (v[r][j][2] * v[r][j][2] + v[r][j][3] * v[r][j][3]);
        const float rstd = rsqrtf(wave_sum(s) * (1.f / DM) + EPS);
        bf16_t* orow = obase + (size_t)(m0 + r * mstride) * DM;
#pragma unroll
        for (int j = 0; j < 8; ++j) { const f32x4 o = v[r][j] * rstd * gg[j]; v[r][j] = o; u32x2 w = {cvt_pk_bf16(o[0], o[1]), cvt_pk_bf16(o[2], o[3])}; *(u32x2*)(orow + 256 * j + 4 * lane) = w; }
        if (h8) { unsigned char* hrow = h8 + (size_t)(m0 + r * mstride) * DM;
#pragma unroll
            for (int j = 0; j < 8; ++j) { const f32x4 y = v[r][j] * H8_SCALE; int p = 0; p = __builtin_amdgcn_cvt_pk_fp8_f32(y[0], y[1], p, false); p = __builtin_amdgcn_cvt_pk_fp8_f32(y[2], y[3], p, true);
                *(unsigned*)(hrow + 256 * j + 4 * lane) = (unsigned)p; } }
        if (xq) { float mx = 0.f;
#pragma unroll
            for (int j = 0; j < 8; ++j) mx = fmaxf(mx, fmaxf(fmaxf(fabsf(v[r][j][0]), fabsf(v[r][j][1])), fmaxf(fabsf(v[r][j][2]), fabsf(v[r][j][3]))));
#pragma unroll
            for (int o = 1; o < 64; o <<= 1) mx = fmaxf(mx, __shfl_xor(mx, o));
            const float sc = mx > 0.f ? 127.f / mx : 0.f;
            unsigned char* qrow = xq + (size_t)(m0 + r * mstride) * DM;
#pragma unroll
            for (int j = 0; j < 8; ++j) *(unsigned*)(qrow + 256 * j + 4 * lane) = pack_i8x4(v[r][j] * sc);
            if (lane == 0) sx[m0 + r * mstride] = mx * (1.f / 127.f); } }
}
__device__ __forceinline__ void fold_unit(int u, const float* wq, const float* keys, bf16_t* WPK, int lane, int wid) {
    const int hp = u >> 4, k0 = (u & 15) * 128, r16 = lane & 15, g4 = lane >> 4;
    bf16x8 A[4];
#pragma unroll
    for (int s = 0; s < 4; ++s) { const float* p = wq + (size_t)(k0 + wid * 16 + r16) * 2048 + hp * 128 + 8 * g4 + 32 * s; A[s] = pack8(*(const f32x4*)p, *(const f32x4*)(p + 4)); }
#pragma unroll 2
    for (int nt = 0; nt < 8; ++nt) { f32x4 c = {0.f, 0.f, 0.f, 0.f};
#pragma unroll
        for (int s = 0; s < 4; ++s) { const float* p = keys + (size_t)(hp * 128 + nt * 16 + r16) * 128 + 8 * g4 + 32 * s;
            c = __builtin_amdgcn_mfma_f32_16x16x32_bf16(A[s], pack8(*(const f32x4*)p, *(const f32x4*)(p + 4)), c, 0, 0, 0); }
        u32x2 w = {cvt_pk_bf16(c[0], c[1]), cvt_pk_bf16(c[2], c[3])};
        *(u32x2*)(WPK + (size_t)(hp * 128 + nt * 16 + r16) * 2048 + k0 + wid * 16 + 4 * g4) = w; }
}

__device__ __forceinline__ void ins16(float (&l)[16], float x) {
#pragma unroll
    for (int k = 15; k >= 1; --k) l[k] = __builtin_amdgcn_fmed3f(l[k - 1], l[k], x);
    l[0] = fmaxf(l[0], x);
}
__device__ __forceinline__ void topk_item(int item, const float* SC, int* RI, float* RG) {
    const int t = item >> 3, h = item & 7;
    const float* srow = SC + (size_t)t * 2048 + h * 256;
    float la[16], lb[16];
#pragma unroll
    for (int k = 0; k < 16; ++k) { la[k] = -__builtin_inff(); lb[k] = -__builtin_inff(); }
#pragma unroll 1
    for (int c = 0; c < 8; ++c) {
        f32x4 va[4], vb[4];
#pragma unroll
        for (int j = 0; j < 4; ++j) { va[j] = *(const f32x4*)(srow + c * 16 + j * 4); vb[j] = *(const f32x4*)(srow + 128 + c * 16 + j * 4); }
#pragma unroll
        for (int j = 0; j < 4; ++j)
#pragma unroll
            for (int e = 0; e < 4; ++e) { const unsigned tag = 127u - (unsigned)(c * 16 + j * 4 + e);
                ins16(la, __uint_as_float((__float_as_uint(va[j][e]) & ~0x7fu) | tag));
                ins16(lb, __uint_as_float((__float_as_uint(vb[j][e]) & ~0x7fu) | tag)); }
    }
    float av[16], bv[16]; int ai[16], bi[16];
#pragma unroll
    for (int k = 0; k < 16; ++k) { const unsigned ua = __float_as_uint(la[k]), ub = __float_as_uint(lb[k]);
        av[k] = __uint_as_float(ua & ~0x7fu); bv[k] = __uint_as_float(ub & ~0x7fu); ai[k] = 127 - (int)(ua & 0x7fu); bi[k] = 127 - (int)(ub & 0x7fu); }
    float lc[16];
#pragma unroll
    for (int k = 0; k < 16; ++k) lc[k] = -__builtin_inff();
#pragma unroll
    for (int i = 0; i < 16; ++i)
#pragma unroll
        for (int j = 0; j < 16; ++j) if ((i + 1) * (j + 1) <= 16) {
            const float sm = av[i] + bv[j]; ins16(lc, __uint_as_float((__float_as_uint(sm) & ~0xffu) | (255u - (unsigned)(i * 16 + j)))); }
    const float thr = lc[15], mxs = __uint_as_float(__float_as_uint(lc[0]) & ~0xffu);
    int cnt = 0; float gsum = 0.f; int* ri = RI + (size_t)t * 128 + h * 16; float* rg = RG + (size_t)t * 128 + h * 16;
#pragma unroll
    for (int i = 0; i < 16; ++i)
#pragma unroll
        for (int j = 0; j < 16; ++j) if ((i + 1) * (j + 1) <= 16) {
            const float sm = av[i] + bv[j]; const float key = __uint_as_float((__float_as_uint(sm) & ~0xffu) | (255u - (unsigned)(i * 16 + j)));
            if (key >= thr && cnt < 16) { const float ev = __expf(sm - mxs); ri[cnt] = (ai[i] * 128 + bi[j]) & 16383; rg[cnt] = ev; gsum += ev; ++cnt; } }
    for (; cnt < 16; ++cnt) { ri[cnt] = 0; rg[cnt] = 0.f; }
    const float ginv = gsum > 0.f ? 1.f / gsum : 0.f;
#pragma unroll
    for (int k = 0; k < 16; ++k) rg[k] *= ginv;
}

typedef float f32x2 __attribute__((ext_vector_type(2)));
#define DPP_ADD(v, CTRL) ((v) + __builtin_bit_cast(float, __builtin_amdgcn_update_dpp(0, __builtin_bit_cast(int, (v)), (CTRL), 0xF, 0xF, true)))
#define DPP_GET(v, CTRL) (__builtin_bit_cast(float, __builtin_amdgcn_update_dpp(0, __builtin_bit_cast(int, (v)), (CTRL), 0xF, 0xF, true)))
__device__ __forceinline__ float gelu_erf(float a) { return 0.5f * a * (1.f + erff(a * 0.70710678118654752f)); }
__device__ __forceinline__ void fp8_row_load(const float* src, f32x4 (&v)[8], int lane) {
#pragma unroll
    for (int q = 0; q < 8; ++q) v[q] = *(const f32x4*)(src + q * 256 + lane * 4);
}
__device__ __forceinline__ void i8_row_store(const f32x4 (&v)[8], unsigned char* tbl, int e, float* scale_out, int lane) {
    float mx = 0.f;
#pragma unroll
    for (int q = 0; q < 8; ++q) mx = fmaxf(mx, fmaxf(fmaxf(fabsf(v[q][0]), fabsf(v[q][1])), fmaxf(fabsf(v[q][2]), fabsf(v[q][3]))));
#pragma unroll
    for (int o = 1; o < 64; o <<= 1) mx = fmaxf(mx, __shfl_xor(mx, o));
    const float sc = mx > 0.f ? 127.f / mx : 0.f;
#pragma unroll
    for (int q = 0; q < 8; ++q) *(unsigned*)(tbl + ((size_t)(2 * q + (lane >> 5)) * 16384 + e) * 128 + (lane & 31) * 4) = pack_i8x4(v[q] * sc);
    if (lane == 0) *scale_out = mx * (1.f / 127.f);
}
__device__ __forceinline__ void fp8_row_store(const f32x4 (&v)[8], unsigned char* tbl, int e, float* scale_out, int lane) {
    float mx = 0.f;
#pragma unroll
    for (int q = 0; q < 8; ++q) mx = fmaxf(mx, fmaxf(fmaxf(fabsf(v[q][0]), fabsf(v[q][1])), fmaxf(fabsf(v[q][2]), fabsf(v[q][3]))));
#pragma unroll
    for (int o = 1; o < 64; o <<= 1) mx = fmaxf(mx, __shfl_xor(mx, o));
    int ex = 7; if (mx > 0.f) (void)frexpf(mx, &ex);
    const float sc = ldexpf(1.f, 7 - ex);
#pragma unroll
    for (int q = 0; q < 8; ++q) { int p = 0; p = __builtin_amdgcn_cvt_pk_fp8_f32(v[q][0] * sc, v[q][1] * sc, p, false); p = __builtin_amdgcn_cvt_pk_fp8_f32(v[q][2] * sc, v[q][3] * sc, p, true);
        *(unsigned*)(tbl + ((size_t)(2 * q + (lane >> 5)) * 16384 + e) * 128 + (lane & 31) * 4) = (unsigned)p; }
    if (lane == 0) *scale_out = ldexpf(1.f, ex - 7);
}
__device__ __forceinline__ void peer_u_sweep(int sl, int t0, int ts, const unsigned char* XQ, const unsigned char* PU8, const int* RI, float* AP, int lane) {
    const int l8 = lane & 7, grp = lane >> 3;
    const unsigned char* tb = PU8 + (size_t)sl * (16384 * 128) + l8 * 16;
    const unsigned char* hb = XQ + sl * 128 + l8 * 16;
    float* apb = AP + (size_t)sl * T * 128 + 64 * (l8 >> 2) + 16 * (l8 & 3) + grp;
#define U_ROUTE(EA, EB, H0, H1, TT) do { EA = RI[(size_t)(TT) * 128 + lane] & 16383; EB = RI[(size_t)(TT) * 128 + 64 + lane] & 16383; \
        H0 = *(const u32x4*)(hb + (size_t)(TT) * 2048); } while (0)
#define U_ISSUE(W, EA, EB) do { _Pragma("unroll") for (int it = 0; it < 16; ++it) { const int e_ = __shfl(it < 8 ? EA : EB, (it & 7) * 8 + grp); W[it] = *(const u32x4*)(tb + (size_t)e_ * 128); } } while (0)
#define U_COMPUTE(W, H0, H1, TT) do { \
        float r_[16]; \
        _Pragma("unroll") for (int it = 0; it < 16; ++it) { int a_ = 0; \
            _Pragma("unroll") for (int d = 0; d < 4; ++d) a_ = __builtin_amdgcn_sdot4((int)W[it][d], (int)H0[d], a_, false);     \
            r_[it] = (float)a_; } \
          \
        float s8_[8], s4_[4], s2_[2]; \
        _Pragma("unroll") for (int k = 0; k < 8; ++k) { const float kp = ub2 ? r_[k + 8] : r_[k], sd = ub2 ? r_[k] : r_[k + 8]; s8_[k] = kp + DPP_GET(sd, 0x141); } \
        _Pragma("unroll") for (int k = 0; k < 4; ++k) { const float kp = ub1 ? s8_[k + 4] : s8_[k], sd = ub1 ? s8_[k] : s8_[k + 4]; s4_[k] = kp + DPP_GET(sd, 0x4E); } \
        _Pragma("unroll") for (int k = 0; k < 2; ++k) { const float kp = ub0 ? s4_[k + 2] : s4_[k], sd = ub0 ? s4_[k] : s4_[k + 2]; s2_[k] = kp + DPP_GET(sd, 0xB1); } \
        float* ap = apb + (size_t)(TT) * 128; ap[0] = s2_[0]; ap[8] = s2_[1]; } while (0)
    const bool ub2 = (l8 & 4) != 0, ub1 = (l8 & 2) != 0, ub0 = (l8 & 1) != 0;
    int t = t0; if (t >= T) return;
    u32x4 wA[16], wB[16]; int eaA, ebA, eaB = 0, ebB = 0, eaN = 0, ebN = 0; u32x4 hA0, hA1, hB0 = {0u, 0u, 0u, 0u}, hB1 = hB0, hN0 = hB0, hN1 = hB0;
    U_ROUTE(eaA, ebA, hA0, hA1, t);
    U_ISSUE(wA, eaA, ebA);
    if (t + ts < T) U_ROUTE(eaB, ebB, hB0, hB1, t + ts);
    for (;;) {
        const bool hasB = t + ts < T, hasA2 = t + 2 * ts < T, hasB2 = t + 3 * ts < T;
        if (hasB) U_ISSUE(wB, eaB, ebB);
        if (hasA2) U_ROUTE(eaN, ebN, hN0, hN1, t + 2 * ts);
        __builtin_amdgcn_sched_barrier(0);
        U_COMPUTE(wA, hA0, hA1, t);
        if (!hasB) break;
        __builtin_amdgcn_sched_barrier(0);
        if (hasA2) U_ISSUE(wA, eaN, ebN);
        hA0 = hN0; hA1 = hN1;
        u32x4 hX0 = hB0, hX1 = hB1;
        if (hasB2) U_ROUTE(eaB, ebB, hB0, hB1, t + 3 * ts);
        __builtin_amdgcn_sched_barrier(0);
        U_COMPUTE(wB, hX0, hX1, t + ts);
        if (!hasA2) break;
        t += 2 * ts;
    }
#undef U_ROUTE
#undef U_ISSUE
#undef U_COMPUTE
}
__device__ __forceinline__ void peer_v_sweep(int sl, int t0, int ts, const unsigned char* PV8, const unsigned* PK, const float* xin, const bf16_t* yin, float* xout, char* ldsw, int lane) {
    const int l8 = lane & 7, grp = lane >> 3;
    const unsigned char* tb = PV8 + (size_t)sl * (16384 * 128) + l8 * 16;
    const float* xb = xin + sl * 128 + l8 * 16 + 2 * grp; const bf16_t* yb = yin + sl * 128 + l8 * 16 + 2 * grp; float* xo = xout + sl * 128 + l8 * 16 + 2 * grp;
    char* lw = ldsw + lane * 64; const char* lr = ldsw + l8 * 64 + grp * 8;
#define V_ROUTE(PA, PB, XV, YV, TT) do { PA = PK[(size_t)(TT) * 128 + lane]; PB = PK[(size_t)(TT) * 128 + 64 + lane]; XV = *(const f32x2*)(xb + (size_t)(TT) * 2048); YV = *(const unsigned*)(yb + (size_t)(TT) * 2048); } while (0)
#define V_ISSUE(W, CW, PA, PB) do { _Pragma("unroll") for (int it = 0; it < 16; ++it) { const unsigned v_ = (unsigned)__shfl((int)(it < 8 ? PA : PB), (it & 7) * 8 + grp); \
        CW[it] = __uint_as_float(v_ & 0xffff0000u); W[it] = *(const u32x4*)(tb + (size_t)(v_ & 16383u) * 128); } } while (0)
#define V_COMPUTE(W, CW, XV, YV, TT) do { f32x2 out[8]; \
        _Pragma("unroll") for (int i = 0; i < 8; ++i) out[i] = (f32x2){0.f, 0.f}; \
        _Pragma("unroll") for (int it = 0; it < 16; ++it) { const f32x2 cw2 = {CW[it], CW[it]}; \
            _Pragma("unroll") for (int d = 0; d < 4; ++d) { out[2 * d] = __builtin_amdgcn_cvt_pk_f32_fp8((int)W[it][d], false) * cw2 + out[2 * d]; out[2 * d + 1] = __builtin_amdgcn_cvt_pk_f32_fp8((int)W[it][d], true) * cw2 + out[2 * d + 1]; } } \
        _Pragma("unroll") for (int i = 0; i < 4; ++i) *(f32x4*)(lw + i * 16) = (f32x4){out[2 * i][0], out[2 * i][1], out[2 * i + 1][0], out[2 * i + 1][1]}; \
        f32x2 acc_ = {XV[0] + bf_lo(YV), XV[1] + bf_hi(YV)}; \
        _Pragma("unroll") for (int g_ = 0; g_ < 8; ++g_) { const f32x2 p_ = *(const f32x2*)(lr + g_ * 512); acc_[0] += p_[0]; acc_[1] += p_[1]; } \
        *(f32x2*)(xo + (size_t)(TT) * 2048) = acc_; } while (0)
    int t = t0; if (t >= T) return;
    u32x4 wA[16], wB[16]; float cwA[16], cwB[16];
    unsigned paA, pbA, paB = 0u, pbB = 0u, paN = 0u, pbN = 0u, yA, yB = 0u, yN = 0u; f32x2 xA, xB = {0.f, 0.f}, xN = {0.f, 0.f};
    V_ROUTE(paA, pbA, xA, yA, t);
    V_ISSUE(wA, cwA, paA, pbA);
    if (t + ts < T) V_ROUTE(paB, pbB, xB, yB, t + ts);
    for (;;) {
        const bool hasB = t + ts < T, hasA2 = t + 2 * ts < T, hasB2 = t + 3 * ts < T;
        if (hasB) V_ISSUE(wB, cwB, paB, pbB);
        if (hasA2) V_ROUTE(paN, pbN, xN, yN, t + 2 * ts);
        __builtin_amdgcn_sched_barrier(0);
        V_COMPUTE(wA, cwA, xA, yA, t);
        if (!hasB) break;
        __builtin_amdgcn_sched_barrier(0);
        if (hasA2) V_ISSUE(wA, cwA, paN, pbN);
        xA = xN; yA = yN;
        const f32x2 xX = xB; const unsigned yX = yB;
        if (hasB2) V_ROUTE(paB, pbB, xB, yB, t + 3 * ts);
        __builtin_amdgcn_sched_barrier(0);
        V_COMPUTE(wB, cwB, xX, yX, t + ts);
        if (!hasA2) break;
        t += 2 * ts;
    }
#undef V_ROUTE
#undef V_ISSUE
#undef V_COMPUTE
}
__device__ __forceinline__ void final_norm_row(int t, float* xio, const float* gfin, int lane) {
    float* xr = xio + (size_t)t * 2048; f32x4 v[8]; float s = 0.f;
#pragma unroll
    for (int j = 0; j < 8; ++j) { v[j] = *(const f32x4*)(xr + 256 * j + 4 * lane); s += (v[j][0] * v[j][0] + v[j][1] * v[j][1]) + (v[j][2] * v[j][2] + v[j][3] * v[j][3]); }
    const float rstd = rsqrtf(wave_sum(s) * (1.f / DM) + EPS);
#pragma unroll
    for (int j = 0; j < 8; ++j) { const f32x4 gg = *(const f32x4*)(gfin + 256 * j + 4 * lane); *(f32x4*)(xr + 256 * j + 4 * lane) = v[j] * rstd * gg; }
}

struct Args {
    const float* x; const int* pos; const float* g_mix; const float* w_in; const float* sinks; const float* g_cq; const float* w_uq; const float* g_ckv; const float* w_ukv;
    const float* w_a; const float* w_b; const float* w_o; const float* g_ffn; const float* w_pq; const float* pkeys; const float* peer_u; const float* peer_v; const float* g_final;
    float* out; unsigned char* ws;
};
constexpr int LDS_BYTES = 147456;
#ifndef PH_MASK
#define PH_MASK 0x3ff
#endif
#define PH(k) if constexpr ((PH_MASK >> (k)) & 1)
#define DBL_PHASE 4
#ifndef DBL_PHASE
#define DBL_PHASE -1
#endif
#define REP(k) _Pragma("unroll 1") for (int rep_ = 0; rep_ < (int)(bst[1] > 100u ? 2 : 1); ++rep_)
#define PHASE_LOCALS size_t wofs_ = 0; asm volatile("" : "+s"(wofs_)); unsigned char* wsb = a.ws + wofs_; const int tid = opaque_tid(), lane = tid & 63, wid = __builtin_amdgcn_readfirstlane(tid >> 6); const int gw = vcu * NWAVES + wid; (void)lane; (void)gw; (void)wsb;

#define WSP(type, off) ((type*)(wsb + (off)))
__global__ void __launch_bounds__(NTHREADS, 2) fwd_mega(Args a) {
    extern __shared__ __attribute__((aligned(16))) unsigned char lds[];
    const int G = gridDim.x, bx = blockIdx.x, vcu = (G % 8 == 0) ? (bx % 8) * (G / 8) + bx / 8 : bx;
    const int NGW = G * NWAVES;
    PG8_LAS unsigned char* ldsg = (PG8_LAS unsigned char*)lds;
    volatile LAS unsigned* bst = (volatile LAS unsigned*)(ldsg + LDS_BYTES - 16);
    if (threadIdx.x == 0) { bst[0] = 0u; bst[1] = 0u; bst[2] = 0u; bst[3] = 0u; }
    __syncthreads();
    const XcdBarrier xbar = xcd_barrier_post((unsigned*)(a.ws + WS_CTL), bst);
#define GRID_SYNC() xcd_barrier(xbar)

    REP(0) {
    PH(0) { PHASE_LOCALS
        LAS float* scr = (LAS float*)(ldsg + wid * 16384);
        constexpr int I_IN = 32 * (IN_WB / 32), I_G = 32 * (IN_WG / 32), I_UQ = 8 * 48, I_UKV = 4 * 64, I_A = 16 * 64, I_O = 32 * 64;
        constexpr int NITEMS = I_IN + I_G + I_UQ + I_UKV + 2 * I_A + I_O;
        for (int it = gw; it < NITEMS; it += NGW) {
            int r = it;
            if (r < I_IN) { const int nb = r % (IN_WB / 32), kb = r / (IN_WB / 32); transpose_item(a.w_in, 2048, IN_W, WSP(bf16_t, WS_WIN), nb * 32, win_src(nb * 32), kb * 64, nullptr, scr, lane); continue; } r -= I_IN;
            if (r < I_G) { const int nb = r % (IN_WG / 32), kb = r / (IN_WG / 32); transpose_item_f8(a.w_in, 2048, IN_W, WSP(unsigned char, WS_WG8), nb * 32, 2368 + nb * 32, kb * 64, WG8_SCALE, scr, lane); continue; } r -= I_G;
            if (r < I_UQ) { const int nb = r % 48, kb = r / 48; transpose_item(a.w_uq, 512, 1536, WSP(bf16_t, WS_WUQ), nb * 32, wuq_src(nb * 32), kb * 64, a.g_cq, scr, lane); continue; } r -= I_UQ;
            if (r < I_UKV) { const int nb = r % 64, kb = r / 64; transpose_item(a.w_ukv, 256, 2048, WSP(bf16_t, WS_WUKV), nb * 32, nb * 32, kb * 64, a.g_ckv, scr, lane); continue; } r -= I_UKV;
            if (r < I_A) { const int nb = r % 64, kb = r / 64; transpose_item(a.w_a, 1024, 2048, WSP(bf16_t, WS_WA), nb * 32, nb * 32, kb * 64, nullptr, scr, lane); continue; } r -= I_A;
            if (r < I_A) { const int nb = r % 64, kb = r / 64; transpose_item(a.w_b, 1024, 2048, WSP(bf16_t, WS_WB), nb * 32, nb * 32, kb * 64, nullptr, scr, lane); continue; } r -= I_A;
            { const int nb = r % 64, kb = r / 64; transpose_item_f8(a.w_o, 2048, 2048, WSP(unsigned char, WS_WO8), nb * 32, nb * 32, kb * 64, WO8_SCALE, scr, lane); }
        }
        for (int r = gw; r < 32768; r += 4 * NGW) {
            f32x4 v0[8], v1[8], v2[8], v3[8];
            const int r1 = r + NGW, r2 = r + 2 * NGW, r3 = r + 3 * NGW;
            fp8_row_load(((r >> 14) ? a.peer_v : a.peer_u) + (size_t)(r & 16383) * 2048, v0, lane);
            fp8_row_load(((r1 >> 14) ? a.peer_v : a.peer_u) + (size_t)(r1 & 16383) * 2048, v1, lane);
            fp8_row_load(((r2 >> 14) ? a.peer_v : a.peer_u) + (size_t)(r2 & 16383) * 2048, v2, lane);
            fp8_row_load(((r3 >> 14) ? a.peer_v : a.peer_u) + (size_t)(r3 & 16383) * 2048, v3, lane);
#define ROW_STORE(V, R) do { if ((R) >> 14) fp8_row_store(V, WSP(unsigned char, WS_PV), (R) & 16383, WSP(float, WS_SCV) + ((R) & 16383), lane); \
                                else i8_row_store(V, WSP(unsigned char, WS_PU), (R) & 16383, WSP(float, WS_SCU) + ((R) & 16383), lane); } while (0)
            ROW_STORE(v0, r); ROW_STORE(v1, r1); ROW_STORE(v2, r2); ROW_STORE(v3, r3); }
#undef ROW_STORE
        { float* cosT = WSP(float, WS_COS); float* sinT = WSP(float, WS_SIN);
          for (int idx = bx * NTHREADS + tid; idx < T * 32; idx += G * NTHREADS) { const int tt = idx >> 5, i = idx & 31;
            const float inv = (float)(1.0 / pow(10000.0, (double)(2 * i) / 64.0)); const float ang = (float)a.pos[tt] * inv;
            cosT[idx] = (float)cos((double)ang); sinT[idx] = (float)sin((double)ang); } }
        for (int m = gw; m < T; m += 4 * NGW) rms_rows_bf16<4>(a.x, nullptr, a.g_mix, WSP(bf16_t, WS_H), m, NGW, lane, nullptr, nullptr, WSP(unsigned char, WS_H8));
        for (int u = bx; u < 256; u += G) fold_unit(u, a.w_pq, a.pkeys, WSP(bf16_t, WS_WPK), lane, wid);
    }
    GRID_SYNC();
    }
    REP(1) {
    PH(1) { PHASE_LOCALS
        { pg8::Gemm g{WSP(bf16_t, WS_H), WSP(bf16_t, WS_WIN), T, IN_WB, 2048, nullptr, nullptr}; pg8::StaticOrder S; S.init(T, IN_WB, G, bx);
          EpiIn E{WSP(bf16_t, WS_QA), WSP(bf16_t, WS_KA), WSP(bf16_t, WS_VA), WSP(bf16_t, WS_CQ), WSP(bf16_t, WS_CKV), WSP(bf16_t, WS_KR), (bf16_t*)a.out, (bf16_t*)a.out + (size_t)T * 2048,
                  WSP(float, WS_SSQ), WSP(float, WS_COS), WSP(float, WS_SIN)};
          pg8::gemm_phase<EpiIn, pg8::StaticOrder, true, true>(ldsg, g, S, E); }
        { pg8::Gemm g{WSP(bf16_t, WS_H8), WSP(bf16_t, WS_WG8), T, IN_WG, 1024, nullptr, nullptr}; pg8::GateOrder S; S.init(T, IN_WG, G, bx);
          EpiGate E{(bf16_t*)a.out, (bf16_t*)a.out + (size_t)T * 2048};
          pg8::gemm_phase<EpiGate, pg8::GateOrder, true, true, true>(ldsg, g, S, E); }
    }
    GRID_SYNC();
    }
    REP(2) {
    PH(2) { PHASE_LOCALS
        { pg8::Gemm g{WSP(bf16_t, WS_CQ), WSP(bf16_t, WS_WUQ), T, 1536, 512, nullptr, nullptr}; pg8::StaticOrder S; S.init(T, 1536, G, bx); EpiQ E{WSP(bf16_t, WS_QN), WSP(bf16_t, WS_QR), WSP(float, WS_SSQ), WSP(float, WS_COS), WSP(float, WS_SIN)};
          pg8::gemm_phase<EpiQ, pg8::StaticOrder, true, true>(ldsg, g, S, E); }
        { pg8::Gemm g{WSP(bf16_t, WS_CKV), WSP(bf16_t, WS_WUKV), T, 2048, 256, nullptr, nullptr}; pg8::StaticOrder S; S.init(T, 2048, G, bx); EpiKV E{WSP(bf16_t, WS_KN), WSP(bf16_t, WS_V), WSP(float, WS_SSQ)};
          pg8::gemm_phase<EpiKV, pg8::StaticOrder, true, true>(ldsg, g, S, E); }
        for (int u = vcu; u < 512; u += G) swa::unit(u, WSP(bf16_t, WS_QA), WSP(bf16_t, WS_KA), WSP(bf16_t, WS_VA), WSP(bf16_t, WS_AA), a.pos, a.sinks, (char*)lds);
    }
    GRID_SYNC();
    }
    REP(3) {
    PH(3) { PHASE_LOCALS mla::phase((char*)lds, vcu, G, WSP(bf16_t, WS_QN), WSP(bf16_t, WS_QR), WSP(bf16_t, WS_KN), WSP(bf16_t, WS_KR), WSP(bf16_t, WS_V), WSP(bf16_t, WS_AB)); }
    GRID_SYNC();
    }
    REP(4) {
    PH(4) { PHASE_LOCALS
        pg8::Gemm g{WSP(bf16_t, WS_AA), WSP(bf16_t, WS_WA), T, 2048, 1024, WSP(bf16_t, WS_AB), WSP(bf16_t, WS_WB)}; pg8::TwoSegOrder S; S.init(T, 2048, G, bx);
        EpiMix2 E{WSP(bf16_t, WS_MX), (const bf16_t*)a.out, (const bf16_t*)a.out + (size_t)T * 2048};
        pg8::gemm_phase<EpiMix2, pg8::TwoSegOrder, true, true>(ldsg, g, S, E);
    }
    GRID_SYNC();
    }
    REP(5) {
    PH(5) { PHASE_LOCALS
        pg8::Gemm g{WSP(bf16_t, WS_MX), WSP(bf16_t, WS_WO8), T, 2048, 1024, nullptr, nullptr}; pg8::StaticOrder S; S.init(T, 2048, G, bx); EpiY E{WSP(bf16_t, WS_Y), 1.f / (MX8_SCALE * WO8_SCALE)};
        pg8::gemm_phase<EpiY, pg8::StaticOrder, true, true, true>(ldsg, g, S, E);
    }
    GRID_SYNC();
    }
    REP(6) {
    PH(6) { PHASE_LOCALS for (int m = gw; m < T; m += 2 * NGW) rms_rows_bf16<2>(a.x, WSP(bf16_t, WS_Y), a.g_ffn, WSP(bf16_t, WS_H), m, NGW, lane, WSP(unsigned char, WS_XQ), WSP(float, WS_SX)); }
    GRID_SYNC();
    }
    REP(7) {
    PH(7) { PHASE_LOCALS
        pg8::Gemm g{WSP(bf16_t, WS_H), WSP(bf16_t, WS_WPK), T, 2048, 2048, nullptr, nullptr}; pg8::StaticOrder S; S.init(T, 2048, G, bx); EpiF32 E{WSP(float, WS_SC)};
        pg8::gemm_phase<EpiF32, pg8::StaticOrder, true, true>(ldsg, g, S, E);
    }
    GRID_SYNC();
    }
    REP(8) {
    PH(8) { PHASE_LOCALS for (int item = bx * NTHREADS + tid; item < T * 8; item += G * NTHREADS) topk_item(item, WSP(float, WS_SC), WSP(int, WS_RI), WSP(float, WS_RG)); }
    GRID_SYNC();
    }
#ifdef DUMP_OFF
    GRID_SYNC();
    { PHASE_LOCALS
      for (size_t i = (size_t)bx * NTHREADS + tid; i < (size_t)T * DM; i += (size_t)G * NTHREADS) {
#ifdef DUMP_F32
          a.out[i] = ((const float*)(wsb + DUMP_OFF))[i];
#else
          a.out[i] = bf_lo((unsigned)((const bf16_t*)(wsb + DUMP_OFF))[i]);
#endif
      } }
#endif
    REP(9) PH(9) { PHASE_LOCALS
        const int nloc = (int)bst[0], nx = (int)bst[1], rank = (int)bst[2], xi = (int)bst[3];
        for (int sl = xi; sl < 16; sl += nx)
            peer_u_sweep(sl, rank * NWAVES + wid, nloc * NWAVES, WSP(unsigned char, WS_XQ), WSP(unsigned char, WS_PU), WSP(int, WS_RI), WSP(float, WS_AP), lane);
    }
    GRID_SYNC();
    REP(9) PH(9) { PHASE_LOCALS
        const float* AP = WSP(float, WS_AP); const int* RI = WSP(int, WS_RI); const float* RG = WSP(float, WS_RG); unsigned* CF = WSP(unsigned, WS_CF);
        const float* SCU = WSP(float, WS_SCU); const float* SCV = WSP(float, WS_SCV);
        for (int idx0 = bx * NTHREADS + tid; idx0 < T * 128; idx0 += 4 * G * NTHREADS) {
            int e[4]; float sacc[4], su[4], sv[4], rg[4];
#pragma unroll
            for (int u = 0; u < 4; ++u) { const int idx = idx0 + u * G * NTHREADS; e[u] = RI[idx] & 16383; rg[u] = RG[idx]; sacc[u] = 0.f; }
#pragma unroll
            for (int u = 0; u < 4; ++u) { const int idx = idx0 + u * G * NTHREADS;
#pragma unroll
                for (int q = 0; q < 16; ++q) sacc[u] += AP[(size_t)q * T * 128 + idx]; }
#pragma unroll
            for (int u = 0; u < 4; ++u) { su[u] = SCU[e[u]]; sv[u] = SCV[e[u]]; }
#pragma unroll
            for (int u = 0; u < 4; ++u) { const float cw = gelu_erf(sacc[u] * su[u] * WSP(float, WS_SX)[(idx0 + u * G * NTHREADS) >> 7]) * rg[u] * sv[u];
                CF[idx0 + u * G * NTHREADS] = (cvt_pk_bf16(0.f, cw) & 0xffff0000u) | (unsigned)e[u]; } }
    }
    GRID_SYNC();
    REP(9) PH(9) { PHASE_LOCALS
        const int nloc = (int)bst[0], nx = (int)bst[1], rank = (int)bst[2], xi = (int)bst[3];
        for (int sl = xi; sl < 16; sl += nx)
            peer_v_sweep(sl, rank * NWAVES + wid, nloc * NWAVES, WSP(unsigned char, WS_PV), WSP(unsigned, WS_CF), a.x, WSP(bf16_t, WS_Y), a.out, (char*)lds + wid * 4096, lane);
    }
    GRID_SYNC();
    REP(9) PH(9) { PHASE_LOCALS for (int t = gw; t < T; t += NGW) final_norm_row(t, a.out, a.g_final, lane); }
}

extern "C" void kernel_launch(void* const* d_in, const int* in_sizes, int n_in, void* d_out, int out_size, void* d_ws, size_t ws_size, hipStream_t stream) {
    static int grid = 0;
    if (grid == 0) {
        if (n_in != 18 || out_size != T * DM || ws_size < WS_END) { fprintf(stderr, "kernel_launch: unexpected shapes n_in %d out %d ws %zu\n", n_in, out_size, ws_size); grid = -1; return; }
        int dev = 0, cus = 0, per_cu = 0;
        (void)hipGetDevice(&dev);
        (void)hipDeviceGetAttribute(&cus, hipDeviceAttributeMultiprocessorCount, dev);
        (void)hipFuncSetAttribute((const void*)fwd_mega, hipFuncAttributeMaxDynamicSharedMemorySize, LDS_BYTES);
        (void)hipOccupancyMaxActiveBlocksPerMultiprocessor(&per_cu, (const void*)fwd_mega, NTHREADS, LDS_BYTES);
        if (per_cu < 1) { fprintf(stderr, "kernel_launch: occupancy query reports %d blocks per CU\n", per_cu); }
        (void)hipGetLastError();
        if (cus < 256) fprintf(stderr, "kernel_launch: built for a 256-CU device (one workgroup per CU); found %d CUs\n", cus);
        grid = 256;
    }
    if (grid < 0) return;
    (void)hipMemsetAsync((char*)d_ws + WS_CTL, 0, CTL_ZERO_BYTES, stream);
    Args a{};
    a.x = (const float*)d_in[0]; a.pos = (const int*)d_in[1]; a.g_mix = (const float*)d_in[2]; a.w_in = (const float*)d_in[3]; a.sinks = (const float*)d_in[4];
    a.g_cq = (const float*)d_in[5]; a.w_uq = (const float*)d_in[6]; a.g_ckv = (const float*)d_in[7]; a.w_ukv = (const float*)d_in[8];
    a.w_a = (const float*)d_in[9]; a.w_b = (const float*)d_in[10]; a.w_o = (const float*)d_in[11]; a.g_ffn = (const float*)d_in[12]; a.w_pq = (const float*)d_in[13];
    a.pkeys = (const float*)d_in[14]; a.peer_u = (const float*)d_in[15]; a.peer_v = (const float*)d_in[16]; a.g_final = (const float*)d_in[17];
    a.out = (float*)d_out; a.ws = (unsigned char*)d_ws;
    void* args[] = {&a};
    hipError_t e = hipLaunchCooperativeKernel((const void*)fwd_mega, dim3(grid), dim3(NTHREADS), args, LDS_BYTES, stream);
    if (e != hipSuccess) fprintf(stderr, "cooperative launch failed: %s (grid %d)\n", hipGetErrorString(e), grid);
}
```
